# Optimizing an MI355X kernel written in HIP

```python
import jax, jax.numpy as jnp
from jax import lax
import numpy as np

D_MODEL = 2048
BATCH = 4
SEQ = 8192
DEPTH = 1

GLA_HEADS = 4
GLA_DK = 256
GLA_DV = 512
GLA_GATE_RANK = 16
GLA_TAU = 16.0
GLA_CHUNK = 64
GLA_QK = GLA_HEADS * GLA_DK
GLA_VW = GLA_HEADS * GLA_DV

DIL_PATTERNS = ((128, 1), (512, 4), (2048, 16))
DIL_GROUPS = len(DIL_PATTERNS)
DIL_HEADS = 8
DIL_HEAD_DIM = 128
DIL_BLOCK = 128
DIL_W = DIL_GROUPS * DIL_HEADS * DIL_HEAD_DIM
DIL_OUT = DIL_HEADS * DIL_HEAD_DIM
ROPE_THETA = 10000.0

IN_SPLITS = (GLA_QK, GLA_QK, GLA_VW, GLA_VW, GLA_GATE_RANK, DIL_W, DIL_W, DIL_W, D_MODEL, D_MODEL)
IN_WIDTH = 2 * GLA_QK + 2 * GLA_VW + GLA_GATE_RANK + 3 * DIL_W + 2 * D_MODEL
VALUE_SEGMENTS = (2, 7)

D_FF = 5632
N_MOD = 9
LN_EPS = 1e-5
DN_ALPHA = (2.0 * DEPTH) ** 0.25
DN_BETA = (8.0 * DEPTH) ** -0.25

kernel_name = "hybrid_gla_dilated_macaron_deepnorm_adaln"


def layer_norm(x, g, b):
    xf = x.astype(jnp.float32)
    mu = jnp.mean(xf, -1, keepdims=True)
    var = jnp.mean(jnp.square(xf - mu), -1, keepdims=True)
    return ((xf - mu) * lax.rsqrt(var + LN_EPS) * g + b).astype(x.dtype)


def modulate(x, shift, scale):
    return x * (1.0 + scale[:, None, :]) + shift[:, None, :]


def swiglu(h, w_gu, w_down):
    gate, up = jnp.split(h @ w_gu, 2, axis=-1)
    return (jax.nn.silu(gate) * up) @ w_down


def rope(t, positions):
    half = t.shape[-1] // 2
    freq = ROPE_THETA ** (-jnp.arange(half, dtype=jnp.float32) / half)
    ang = positions.astype(jnp.float32)[..., None] * freq
    cos = jnp.cos(ang)[:, :, None, :]
    sin = jnp.sin(ang)[:, :, None, :]
    t1, t2 = t[..., :half].astype(jnp.float32), t[..., half:].astype(jnp.float32)
    return jnp.concatenate([t1 * cos - t2 * sin, t2 * cos + t1 * sin], -1).astype(t.dtype)


def gla_chunked(q, k, v, log_a):
    B, S, H, Dk = q.shape
    Dv = v.shape[-1]
    C = GLA_CHUNK
    nc = S // C

    def to_chunks(t):
        return t.astype(jnp.float32).reshape(B, nc, C, H, -1).transpose(1, 0, 3, 2, 4)

    qc, kc, vc, ac = to_chunks(q), to_chunks(k), to_chunks(v), to_chunks(log_a)
    b = jnp.cumsum(ac, axis=3)
    b_last = b[:, :, :, -1:, :]
    q_dec = qc * jnp.exp(b) * (Dk ** -0.5)
    k_inv = kc * jnp.exp(-b)
    k_end = kc * jnp.exp(b_last - b)
    causal = jnp.tril(jnp.ones((C, C), dtype=bool))
    a_intra = jnp.where(causal, jnp.einsum('nbhcd,nbhsd->nbhcs', q_dec, k_inv), 0.0)
    o_intra = jnp.einsum('nbhcs,nbhse->nbhce', a_intra, vc)
    decay = jnp.exp(b_last[:, :, :, 0, :])

    def step(state, inp):
        q_i, k_i, v_i, d_i = inp
        o_i = jnp.einsum('bhcd,bhde->bhce', q_i, state)
        state = d_i[..., None] * state + jnp.einsum('bhcd,bhce->bhde', k_i, v_i)
        return state, o_i

    state0 = jnp.zeros((B, H, Dk, Dv), jnp.float32)
    _, o_inter = lax.scan(step, state0, (q_dec, k_end, vc, decay))
    return (o_intra + o_inter).transpose(1, 0, 3, 2, 4).reshape(B, S, H, Dv)


def dilated_window_attention(q, k, v, window, dilation):
    B, S, H, Dh = q.shape
    r = dilation
    L = S // r
    W = window // r
    nb = -(-L // DIL_BLOCK)
    Lp = nb * DIL_BLOCK

    def strided_blocks(t):
        t = t.reshape(B, L, r, H, Dh).transpose(0, 2, 1, 3, 4)
        t = jnp.pad(t, ((0, 0), (0, 0), (0, Lp - L), (0, 0), (0, 0)))
        return t.reshape(B, r, nb, DIL_BLOCK, H, Dh)

    def with_previous_block(t):
        prev = jnp.pad(t, ((0, 0), (0, 0), (1, 0), (0, 0), (0, 0), (0, 0)))[:, :, :-1]
        return jnp.concatenate([prev, t], axis=3)

    qb = strided_blocks(q)
    kk = with_previous_block(strided_blocks(k))
    vv = with_previous_block(strided_blocks(v))
    s = jnp.einsum('brnqhd,brnkhd->brnhqk', qb, kk).astype(jnp.float32) * (Dh ** -0.5)
    qi = jnp.arange(DIL_BLOCK)[:, None]
    kj = jnp.arange(2 * DIL_BLOCK)[None, :]
    rel = qi + DIL_BLOCK - kj
    band = (rel >= 0) & (rel <= W)
    after_start = (jnp.arange(nb)[:, None, None] > 0) | (kj >= DIL_BLOCK)[None]
    mask = band[None] & after_start
    s = jnp.where(mask[None, None, :, None], s, -jnp.inf)
    m = jnp.max(s, -1, keepdims=True)
    p = jnp.exp(s - m)
    den = jnp.sum(p, -1, keepdims=True)
    o = jnp.einsum('brnhqk,brnkhd->brnhqd', p, vv.astype(jnp.float32)) / den
    lse = (m + jnp.log(den))[..., 0]
    o = o.transpose(0, 1, 2, 4, 3, 5).reshape(B, r, Lp, H, Dh)[:, :, :L]
    o = o.transpose(0, 2, 1, 3, 4).reshape(B, S, H, Dh)
    lse = lse.transpose(0, 1, 2, 4, 3).reshape(B, r, Lp, H)[:, :, :L]
    lse = lse.transpose(0, 2, 1, 3).reshape(B, S, H)
    return o, lse


def hybrid_mixer(h, positions, w_in, w_alpha2, b_alpha, gla_norm_g, w_branch_a, w_branch_b, w_out):
    B, S, _ = h.shape
    split_points = [int(p) for p in np.cumsum(IN_SPLITS)[:-1]]
    (gq, gk, gv, gr, g_lr, dq, dk, dv, gate_a, gate_b) = jnp.split(h @ w_in, split_points, axis=-1)

    gate_logits = (g_lr @ w_alpha2 + b_alpha).astype(jnp.float32)
    log_a = jax.nn.log_sigmoid(gate_logits) / GLA_TAU
    o_a = gla_chunked(gq.reshape(B, S, GLA_HEADS, GLA_DK),
                      gk.reshape(B, S, GLA_HEADS, GLA_DK),
                      gv.reshape(B, S, GLA_HEADS, GLA_DV),
                      log_a.reshape(B, S, GLA_HEADS, GLA_DK))
    o_a = o_a * lax.rsqrt(jnp.mean(jnp.square(o_a), -1, keepdims=True) + LN_EPS) * gla_norm_g
    o_a = o_a.reshape(B, S, GLA_VW).astype(h.dtype) * jax.nn.silu(gr)
    y_a = o_a @ w_branch_a

    dq = rope(dq.reshape(B, S, DIL_GROUPS * DIL_HEADS, DIL_HEAD_DIM), positions)
    dk = rope(dk.reshape(B, S, DIL_GROUPS * DIL_HEADS, DIL_HEAD_DIM), positions)
    dq = dq.reshape(B, S, DIL_GROUPS, DIL_HEADS, DIL_HEAD_DIM)
    dk = dk.reshape(B, S, DIL_GROUPS, DIL_HEADS, DIL_HEAD_DIM)
    dv = dv.reshape(B, S, DIL_GROUPS, DIL_HEADS, DIL_HEAD_DIM)
    outs, lses = [], []
    for g, (window, dilation) in enumerate(DIL_PATTERNS):
        o_g, lse_g = dilated_window_attention(dq[:, :, g], dk[:, :, g], dv[:, :, g], window, dilation)
        outs.append(o_g)
        lses.append(lse_g)
    wts = jax.nn.softmax(jnp.stack(lses, 0), axis=0)
    o_b = jnp.sum(wts[..., None] * jnp.stack(outs, 0), axis=0)
    y_b = o_b.reshape(B, S, DIL_OUT).astype(h.dtype) @ w_branch_b

    merged = jax.nn.sigmoid(gate_a) * y_a + jax.nn.sigmoid(gate_b) * y_b
    return merged @ w_out


def setup_inputs(seed: int = 0) -> dict:
    key = jax.random.key(seed)
    ks = jax.random.split(key, 24)
    f32 = jnp.float32
    nrm = lambda k, shape, s: jax.random.normal(k, shape, f32) * s
    col_scale = jnp.concatenate([jnp.full((w,), DN_BETA if i in VALUE_SEGMENTS else 1.0, f32)
                                 for i, w in enumerate(IN_SPLITS)])
    return {
        "x": nrm(ks[0], (BATCH, SEQ, D_MODEL), 1.0),
        "c": nrm(ks[1], (BATCH, D_MODEL), 1.0),
        "positions": jnp.broadcast_to(jnp.arange(SEQ, dtype=jnp.int32), (BATCH, SEQ)),
        "w_ada": nrm(ks[2], (DEPTH, D_MODEL, N_MOD * D_MODEL), D_MODEL ** -0.5),
        "b_ada": nrm(ks[3], (DEPTH, N_MOD * D_MODEL), 0.02),
        "ln1_g": 1.0 + nrm(ks[4], (DEPTH, D_MODEL), 0.02),
        "ln1_b": nrm(ks[5], (DEPTH, D_MODEL), 0.02),
        "w_ffn1_gu": nrm(ks[6], (DEPTH, D_MODEL, 2 * D_FF), D_MODEL ** -0.5),
        "w_ffn1_down": nrm(ks[7], (DEPTH, D_FF, D_MODEL), DN_BETA * D_FF ** -0.5),
        "w_in": nrm(ks[8], (DEPTH, D_MODEL, IN_WIDTH), D_MODEL ** -0.5) * col_scale,
        "w_alpha2": nrm(ks[9], (DEPTH, GLA_GATE_RANK, GLA_QK), GLA_GATE_RANK ** -0.5),
        "b_alpha": nrm(ks[10], (DEPTH, GLA_QK), 0.1),
        "gla_norm_g": 1.0 + nrm(ks[11], (DEPTH, GLA_HEADS, GLA_DV), 0.02),
        "w_branch_a": nrm(ks[12], (DEPTH, GLA_VW, D_MODEL), GLA_VW ** -0.5),
        "w_branch_b": nrm(ks[13], (DEPTH, DIL_OUT, D_MODEL), DIL_OUT ** -0.5),
        "w_out": nrm(ks[14], (DEPTH, D_MODEL, D_MODEL), DN_BETA * D_MODEL ** -0.5),
        "ln2_g": 1.0 + nrm(ks[15], (DEPTH, D_MODEL), 0.02),
        "ln2_b": nrm(ks[16], (DEPTH, D_MODEL), 0.02),
        "w_ffn2_gu": nrm(ks[17], (DEPTH, D_MODEL, 2 * D_FF), D_MODEL ** -0.5),
        "w_ffn2_down": nrm(ks[18], (DEPTH, D_FF, D_MODEL), DN_BETA * D_FF ** -0.5),
        "ln3_g": 1.0 + nrm(ks[19], (DEPTH, D_MODEL), 0.02),
        "ln3_b": nrm(ks[20], (DEPTH, D_MODEL), 0.02),
    }


def reference(x, c, positions, w_ada, b_ada, ln1_g, ln1_b, w_ffn1_gu, w_ffn1_down,
              w_in, w_alpha2, b_alpha, gla_norm_g, w_branch_a, w_branch_b, w_out,
              ln2_g, ln2_b, w_ffn2_gu, w_ffn2_down, ln3_g, ln3_b):
    c_act = jax.nn.silu(c)
    for l in range(DEPTH):
        mods = c_act @ w_ada[l] + b_ada[l]
        sh1, sc1, g1, sh2, sc2, g2, sh3, sc3, g3 = jnp.split(mods, N_MOD, axis=-1)
        f1 = swiglu(modulate(x, sh1, sc1), w_ffn1_gu[l], w_ffn1_down[l])
        x = layer_norm(DN_ALPHA * x + 0.5 * g1[:, None, :] * f1, ln1_g[l], ln1_b[l])
        m = hybrid_mixer(modulate(x, sh2, sc2), positions, w_in[l], w_alpha2[l], b_alpha[l],
                         gla_norm_g[l], w_branch_a[l], w_branch_b[l], w_out[l])
        x = layer_norm(DN_ALPHA * x + g2[:, None, :] * m, ln2_g[l], ln2_b[l])
        f2 = swiglu(modulate(x, sh3, sc3), w_ffn2_gu[l], w_ffn2_down[l])
        x = layer_norm(DN_ALPHA * x + 0.5 * g3[:, None, :] * f2, ln3_g[l], ln3_b[l])
    return x
```

```cpp
#include <hip/hip_runtime.h>
#include <hip/hip_cooperative_groups.h>
#include <cstdio>
#include <cstdint>
namespace cg = cooperative_groups;

#define LAS __attribute__((address_space(3)))
typedef unsigned short bf16_t;
typedef short bf16x8 __attribute__((ext_vector_type(8)));
typedef short s16x4 __attribute__((ext_vector_type(4)));
typedef float f32x4 __attribute__((ext_vector_type(4)));
typedef float f32x2 __attribute__((ext_vector_type(2)));
typedef unsigned u32x4 __attribute__((ext_vector_type(4)));
typedef unsigned u32x2 __attribute__((ext_vector_type(2)));

__device__ __forceinline__ int tid_local() { int t = threadIdx.x; asm volatile("" : "+v"(t)); return t; }

namespace pg8 {
constexpr int BM = 256, BK = 64, HALF = 128, HTB = HALF * BK * 2, STAGE_BYTES = 8 * HTB, NXCD = 8, WGM = 8;
__host__ __device__ __forceinline__ int lds_byte(int r, int c) { const int st = (r >> 4) * 2 + (c >> 5), rr = r & 15, cc = c & 31, ob = rr * 64 + cc * 2; return st * 1024 + (ob ^ (((ob >> 9) & 1) << 5)); }
__host__ __device__ __forceinline__ void stage_rc(int b, int& R, int& C) { const int st = b / 1024, sb = b % 1024, swz = sb ^ (((sb >> 9) & 1) << 5); R = (st >> 1) * 16 + swz / 64; C = (st & 1) * 32 + (swz % 64) / 2; }
__host__ __device__ __forceinline__ int perm32(int rho) { const int n = rho >> 4, i = rho & 15; return 8 * (i >> 2) + 4 * n + (i & 3); }
struct Unit { int pm, pn; };
struct Gemm { const bf16_t* A; const bf16_t* Bt; int M, N, K; };
struct StaticOrder {
    int nM, nN, nwg, G, c;
    __device__ void init(int M, int N, int G_, int c_) { nM = M / BM; nN = N / BM; nwg = nM * nN; G = G_; c = c_; }
    __device__ bool next(int i, Unit& u) const {
        const long L = (long)i * G + c; if (L >= nwg) return false;
        int wgid = (int)L; { const int q = nwg / NXCD, r = nwg % NXCD, xcd = wgid % NXCD, off = wgid / NXCD; wgid = (xcd < r ? xcd * (q + 1) : r * (q + 1) + (xcd - r) * q) + off; }
        const int nig = WGM * nN, gid = wgid / nig, fm = gid * WGM, gsz = (nM - fm) < WGM ? (nM - fm) : WGM;
        u.pm = fm + ((wgid % nig) % gsz); u.pn = (wgid % nig) / gsz; return true;
    }
    __device__ __forceinline__ void a_ready(const Unit&) const {}
    __device__ __forceinline__ void done(const Unit&) const {}
};
typedef float f32x2_t __attribute__((ext_vector_type(2)));
typedef __bf16 bf16x2_t __attribute__((ext_vector_type(2)));
__device__ __forceinline__ unsigned cvt_pk_bf16(float lo, float hi) { f32x2_t v = {lo, hi}; bf16x2_t b = __builtin_convertvector(v, bf16x2_t); return __builtin_bit_cast(unsigned, b); }

template <class Epi, class Sched, bool ALIGN_EPI = false, bool SP2 = false>
__device__ __forceinline__ void gemm_phase(LAS unsigned char* lds, const Gemm g, const Sched& S, const Epi& E) {
    const int tid = tid_local(), wid = __builtin_amdgcn_readfirstlane(tid >> 6), lane = tid & 63, wr = wid >> 2, wc = wid & 3, fr = lane & 15, fq = lane >> 4;
    const int K = g.K, nt = K / BK;
    unsigned voffA[2], voffB[2];
#pragma unroll
    for (int i = 0; i < 2; ++i) { int R, C; stage_rc(tid * 16 + i * 8192, R, C); const int Rb = Epi::PERM ? ((R & ~31) + perm32(R & 31)) : R;
        voffA[i] = (unsigned)(R * K + C) * 2u; voffB[i] = (unsigned)(Rb * K + C) * 2u; }
    const size_t kstep = (size_t)(BK * 2);
    const size_t hstep = (size_t)HALF * K * 2;
    const size_t tstep = 2 * hstep;
    const unsigned ldsw = (unsigned)wid * 1024u;
    const int aoff = lds_byte(wr * 64 + fr, fq * 8), boff = lds_byte(wc * 32 + fr, fq * 8);
#define PG8_SA(b, h) (((b) * 2 + (h)) * HTB)
#define PG8_SB(b, h) ((4 + (b) * 2 + (h)) * HTB)
#define PG8_STAGE(bufoff, gbase, voff) do { _Pragma("unroll") for (int _i = 0; _i < 2; ++_i) \
        __builtin_amdgcn_global_load_lds((const unsigned*)((const char*)(gbase) + (voff)[_i]), (LAS unsigned*)(lds + (bufoff) + ldsw + _i * 8192), 16, 0, 0); } while (0)
#define PG8_LDA(dst, b, h) do { _Pragma("unroll") for (int m = 0; m < 4; ++m) _Pragma("unroll") for (int k = 0; k < 2; ++k) dst[m][k] = *(const LAS bf16x8*)(lds + PG8_SA(b, h) + aoff + m * 2048 + k * 1024); } while (0)
#define PG8_LDB(dst, b, h) do { _Pragma("unroll") for (int n = 0; n < 2; ++n) _Pragma("unroll") for (int k = 0; k < 2; ++k) dst[n][k] = *(const LAS bf16x8*)(lds + PG8_SB(b, h) + boff + n * 2048 + k * 1024); } while (0)
#define PG8_MMA(ai, bj, At, Bt) do { __builtin_amdgcn_s_setprio(1); _Pragma("unroll") for (int m = 0; m < 4; ++m) _Pragma("unroll") for (int n = 0; n < 2; ++n) _Pragma("unroll") for (int k = 0; k < 2; ++k) \
        acc[ai][bj][m][n] = __builtin_amdgcn_mfma_f32_16x16x32_bf16(Bt[n][k], At[m][k], acc[ai][bj][m][n], 0, 0, 0); __builtin_amdgcn_s_setprio(0); } while (0)
#define PG8_WAIT_V(n) asm volatile("s_waitcnt vmcnt(" #n ")" ::: "memory")
#define PG8_WAIT_L(n) asm volatile("s_waitcnt lgkmcnt(" #n ")" ::: "memory")
#define PG8_BAR __builtin_amdgcn_s_barrier()
#define PG8_SCHED __builtin_amdgcn_sched_barrier(0)
    Unit cur, nxt; int ui = 0;
    if (!S.next(0, cur)) return;
    f32x4 acc[2][2][4][2];
#pragma unroll
    for (int a = 0; a < 2; ++a)
#pragma unroll
        for (int b = 0; b < 2; ++b)
#pragma unroll
            for (int m = 0; m < 4; ++m)
#pragma unroll
                for (int n = 0; n < 2; ++n) acc[a][b][m][n] = (f32x4){0.f, 0.f, 0.f, 0.f};
    bf16x8 At[4][2], B0[2][2], B1[2][2];
    const char* cA = (const char*)g.A + (size_t)cur.pm * tstep; const char* cB = (const char*)g.Bt + (size_t)cur.pn * tstep;
    S.a_ready(cur);
    if constexpr (SP2) {
        PG8_STAGE(PG8_SB(0, 0), cB, voffB); PG8_STAGE(PG8_SB(0, 1), cB + hstep, voffB); PG8_STAGE(PG8_SA(0, 0), cA, voffA); PG8_STAGE(PG8_SA(0, 1), cA + hstep, voffA);
        if (wr == 1) PG8_BAR;
        PG8_WAIT_V(2); PG8_BAR;
        PG8_STAGE(PG8_SB(1, 0), cB + kstep, voffB); PG8_STAGE(PG8_SA(1, 0), cA + kstep, voffA); PG8_STAGE(PG8_SB(1, 1), cB + hstep + kstep, voffB);
        PG8_WAIT_V(6); PG8_BAR;
    } else {
        PG8_STAGE(PG8_SB(0, 0), cB, voffB); PG8_STAGE(PG8_SA(0, 0), cA, voffA); PG8_STAGE(PG8_SB(0, 1), cB + hstep, voffB); PG8_STAGE(PG8_SA(0, 1), cA + hstep, voffA);
        if (wr == 1) PG8_BAR;
        PG8_WAIT_V(4); PG8_BAR;
        PG8_STAGE(PG8_SB(1, 0), cB + kstep, voffB); PG8_STAGE(PG8_SA(1, 0), cA + kstep, voffA); PG8_STAGE(PG8_SB(1, 1), cB + hstep + kstep, voffB);
        PG8_WAIT_V(6); PG8_BAR;
    }
    for (;;) {
        const bool has_next = S.next(ui + 1, nxt);
        const char* nA = has_next ? (const char*)g.A + (size_t)nxt.pm * tstep : cA; const char* nB = has_next ? (const char*)g.Bt + (size_t)nxt.pn * tstep : cB;
        for (int t = 0; t < nt; t += 2) {
            const bool last = (t == nt - 2);
            const char* a1 = cA + (size_t)(t + 1) * kstep;
            const char* a2 = last ? nA : cA + (size_t)(t + 2) * kstep; const char* b2 = last ? nB : cB + (size_t)(t + 2) * kstep;
            const char* a3 = a2 + kstep; const char* b3 = b2 + kstep;
            if (last && has_next) S.a_ready(nxt);
            if constexpr (SP2) {
            PG8_LDB(B0, 0, 0); PG8_LDB(B1, 0, 1); PG8_SCHED; PG8_LDA(At, 0, 0); PG8_STAGE(PG8_SA(1, 1), a1 + hstep, voffA);
            PG8_WAIT_V(8); PG8_WAIT_L(0); PG8_BAR; PG8_MMA(0, 0, At, B0); PG8_MMA(0, 1, At, B1); PG8_BAR; PG8_SCHED;
            PG8_LDA(At, 0, 1); PG8_STAGE(PG8_SB(0, 0), b2, voffB); PG8_STAGE(PG8_SB(0, 1), b2 + hstep, voffB); PG8_STAGE(PG8_SA(0, 0), a2, voffA);
            PG8_WAIT_V(8); PG8_WAIT_L(0); PG8_BAR; PG8_MMA(1, 0, At, B0); PG8_MMA(1, 1, At, B1); PG8_BAR; PG8_SCHED;
            PG8_LDB(B0, 1, 0); PG8_LDB(B1, 1, 1); PG8_SCHED; PG8_LDA(At, 1, 0); PG8_STAGE(PG8_SA(0, 1), a2 + hstep, voffA);
            PG8_WAIT_V(8); PG8_WAIT_L(0); PG8_BAR; PG8_MMA(0, 0, At, B0); PG8_MMA(0, 1, At, B1); PG8_BAR; PG8_SCHED;
            PG8_LDA(At, 1, 1); PG8_STAGE(PG8_SB(1, 0), b3, voffB); PG8_STAGE(PG8_SB(1, 1), b3 + hstep, voffB); PG8_STAGE(PG8_SA(1, 0), a3, voffA);
            PG8_WAIT_V(8); PG8_WAIT_L(0); PG8_BAR; PG8_MMA(1, 0, At, B0); PG8_MMA(1, 1, At, B1); PG8_BAR; PG8_SCHED;
            } else {
            PG8_LDB(B0, 0, 0); PG8_SCHED; PG8_LDA(At, 0, 0); PG8_STAGE(PG8_SA(1, 1), a1 + hstep, voffA);
            PG8_WAIT_L(8); PG8_BAR; PG8_WAIT_L(0); PG8_MMA(0, 0, At, B0); PG8_BAR; PG8_SCHED;
            PG8_LDB(B1, 0, 1); PG8_STAGE(PG8_SB(0, 0), b2, voffB);
            PG8_BAR; PG8_WAIT_L(0); PG8_MMA(0, 1, At, B1); PG8_BAR;
            PG8_LDA(At, 0, 1); PG8_STAGE(PG8_SA(0, 0), a2, voffA);
            PG8_BAR; PG8_WAIT_L(0); PG8_MMA(1, 0, At, B0); PG8_BAR; PG8_SCHED;
            PG8_STAGE(PG8_SB(0, 1), b2 + hstep, voffB);
            PG8_WAIT_V(6); PG8_BAR; PG8_MMA(1, 1, At, B1); PG8_BAR;
            PG8_LDB(B0, 1, 0); PG8_SCHED; PG8_LDA(At, 1, 0); PG8_STAGE(PG8_SA(0, 1), a2 + hstep, voffA);
            PG8_WAIT_L(8); PG8_BAR; PG8_WAIT_L(0); PG8_MMA(0, 0, At, B0); PG8_BAR; PG8_SCHED;
            PG8_LDB(B1, 1, 1); PG8_STAGE(PG8_SB(1, 0), b3, voffB);
            PG8_BAR; PG8_WAIT_L(0); PG8_MMA(0, 1, At, B1); PG8_BAR;
            PG8_LDA(At, 1, 1); PG8_STAGE(PG8_SA(1, 0), a3, voffA);
            PG8_BAR; PG8_WAIT_L(0); PG8_MMA(1, 0, At, B0); PG8_BAR; PG8_SCHED;
            PG8_STAGE(PG8_SB(1, 1), b3 + hstep, voffB);
            PG8_WAIT_V(6); PG8_BAR; PG8_MMA(1, 1, At, B1); PG8_BAR;
            }
        }
        if constexpr (ALIGN_EPI) { if (wr == 0) PG8_BAR; }
        E(acc, cur, wr, wc, fr, fq);
        if (!has_next) break;
#pragma unroll
        for (int a = 0; a < 2; ++a)
#pragma unroll
            for (int b = 0; b < 2; ++b)
#pragma unroll
                for (int m = 0; m < 4; ++m)
#pragma unroll
                    for (int n = 0; n < 2; ++n) acc[a][b][m][n] = (f32x4){0.f, 0.f, 0.f, 0.f};
        cur = nxt; cA = nA; cB = nB; ++ui;
        if constexpr (ALIGN_EPI) { if (wr == 1) PG8_BAR; }
    }
    PG8_WAIT_V(0);
    if constexpr (!ALIGN_EPI) { if (wr == 0) PG8_BAR; }
    PG8_BAR;
#undef PG8_SA
#undef PG8_SB
#undef PG8_STAGE
#undef PG8_LDA
#undef PG8_LDB
#undef PG8_MMA
#undef PG8_WAIT_V
#undef PG8_WAIT_L
#undef PG8_BAR
#undef PG8_SCHED
}
}

constexpr int NB = 4, SEQ = 8192, T = NB * SEQ, D = 2048, FF = 5632, NMOD = 9;
constexpr int TH = T / 2;
constexpr float LN_EPS = 1e-5f;
constexpr float DN_ALPHA = 1.189207115002721f;
constexpr int WIN_SRC = 19472;
constexpr int WIN_ROWS = 77 * 256;
constexpr int WR_GLA = 0, WR_GLR = 6144, WR_DQ = 6400, WR_DK = 9472, WR_DV = 12544, WR_GATE = 15616;

constexpr size_t MiB = 1u << 20;
constexpr size_t WS_MODS = 0;
constexpr size_t CTL_ZERO_BYTES = 1 * MiB;
constexpr size_t WS_GLR = 1 * MiB;
constexpr size_t WS_AIN = 3 * MiB;
constexpr size_t WS_COS = 3 * MiB, WS_SIN = 11 * MiB;
constexpr size_t WS_DEC = 19 * MiB;
constexpr size_t WS_LSE = 21 * MiB;
constexpr size_t WS_WGU = 23 * MiB;
constexpr size_t WS_WD = 67 * MiB;
constexpr size_t WS_WIN = 89 * MiB;
constexpr size_t WS_WA = 166 * MiB, WS_WB = 174 * MiB, WS_WO = 178 * MiB;
constexpr size_t WS_H = 186 * MiB;
constexpr size_t WS_ACT = 314 * MiB;
constexpr size_t WS_Q = 314 * MiB, WS_K = 378 * MiB, WS_V = 442 * MiB, WS_R = 570 * MiB, WS_ORAW = 698 * MiB;
constexpr size_t WS_OA = 314 * MiB;
constexpr size_t WS_DQ = 442 * MiB, WS_DK = 538 * MiB, WS_DV = 634 * MiB;
constexpr size_t WS_OB = 730 * MiB;
constexpr size_t WS_OG = 794 * MiB;
constexpr size_t WS_SGA = 442 * MiB, WS_SGB = 570 * MiB;
constexpr size_t WS_END = 954 * MiB;

constexpr int LDS_BYTES = 147456;

struct Args {
    const float* x; const float* c; const int* pos; const float* w_ada; const float* b_ada;
    const float* ln1_g; const float* ln1_b; const float* w_gu1; const float* w_d1;
    const float* w_in; const float* w_alpha2; const float* b_alpha; const float* gla_g;
    const float* w_a; const float* w_b; const float* w_o; const float* ln2_g; const float* ln2_b;
    const float* w_gu2; const float* w_d2; const float* ln3_g; const float* ln3_b;
    float* out; unsigned char* ws;
};

typedef const Args __attribute__((address_space(4)))* CArgs;
__device__ __forceinline__ CArgs launder(CArgs p) { asm volatile("" : "+s"(p)); return p; }

__device__ __forceinline__ unsigned pk2(float lo, float hi) { return pg8::cvt_pk_bf16(lo, hi); }
__device__ __forceinline__ float bf_lo(unsigned w) { return __uint_as_float(w << 16); }
__device__ __forceinline__ float bf_hi(unsigned w) { return __uint_as_float(w & 0xffff0000u); }
__device__ __forceinline__ float bf2f(bf16_t h) { return __uint_as_float(((unsigned)h) << 16); }
__device__ __forceinline__ bf16_t f2bf(float f) { unsigned u = __float_as_uint(f); return (bf16_t)((u + 0x7fffu + ((u >> 16) & 1u)) >> 16); }
__device__ __forceinline__ float fast_rcp(float x) { return __builtin_amdgcn_rcpf(x); }
__device__ __forceinline__ float sigmoidf_(float x) { return fast_rcp(1.0f + __expf(-x)); }
__device__ __forceinline__ float siluf_(float x) { return x * sigmoidf_(x); }
__device__ __forceinline__ float wave_sum(float v) {
#pragma unroll
    for (int o = 1; o < 64; o <<= 1) v += __shfl_xor(v, o);
    return v;
}
__device__ __forceinline__ s16x4 tr4(const LAS unsigned char* p) { return __builtin_bit_cast(s16x4, __builtin_amdgcn_ds_read_tr16_b64_v4i16((LAS s16x4*)p)); }
__device__ __forceinline__ bf16x8 cat8(s16x4 a, s16x4 b) { return (bf16x8){a[0], a[1], a[2], a[3], b[0], b[1], b[2], b[3]}; }
#define MFMA16(a, b, c) __builtin_amdgcn_mfma_f32_16x16x32_bf16((a), (b), (c), 0, 0, 0)

struct EpiGU {
    static constexpr bool PERM = true;
    bf16_t* O;
    __device__ __forceinline__ void operator()(const f32x4 (&acc)[2][2][4][2], const pg8::Unit& u, int wr, int wc, int fr, int fq) const {
        const int row0 = u.pm * 256 + wr * 64 + fr, col0 = u.pn * 128 + wc * 32 + 8 * fq;
#pragma unroll
        for (int ai = 0; ai < 2; ++ai)
#pragma unroll
            for (int m = 0; m < 4; ++m) {
                const f32x4 g0 = acc[ai][0][m][0], g1 = acc[ai][0][m][1], u0 = acc[ai][1][m][0], u1 = acc[ai][1][m][1];
                u32x4 w;
                w.x = pk2(siluf_(g0[0]) * u0[0], siluf_(g0[1]) * u0[1]); w.y = pk2(siluf_(g0[2]) * u0[2], siluf_(g0[3]) * u0[3]);
                w.z = pk2(siluf_(g1[0]) * u1[0], siluf_(g1[1]) * u1[1]); w.w = pk2(siluf_(g1[2]) * u1[2], siluf_(g1[3]) * u1[3]);
                __builtin_nontemporal_store(w, (u32x4*)(O + (size_t)(row0 + ai * 128 + m * 16) * FF + col0));
            }
    }
};
struct EpiRes {
    static constexpr bool PERM = false;
    const float* res; float* out; const float* gate; float gs;
    __device__ __forceinline__ void operator()(const f32x4 (&acc)[2][2][4][2], const pg8::Unit& u, int wr, int wc, int fr, int fq) const {
        const int row0 = u.pm * 256 + wr * 64 + fr, col0 = u.pn * 256 + wc * 32 + 4 * fq;
        const float* gp = gate + (size_t)(u.pm >> 5) * (NMOD * D) + col0;
        f32x4 gv[2][2];
#pragma unroll
        for (int bj = 0; bj < 2; ++bj)
#pragma unroll
            for (int n = 0; n < 2; ++n) gv[bj][n] = *(const f32x4*)(gp + bj * 128 + n * 16) * gs;
#pragma unroll
        for (int ai = 0; ai < 2; ++ai)
#pragma unroll
            for (int m = 0; m < 4; ++m) {
                const size_t off = (size_t)(row0 + ai * 128 + m * 16) * D + col0;
#pragma unroll
                for (int bj = 0; bj < 2; ++bj)
#pragma unroll
                    for (int n = 0; n < 2; ++n) {
                        const f32x4 r = *(const f32x4*)(res + off + bj * 128 + n * 16);
                        *(f32x4*)(out + off + bj * 128 + n * 16) = r * DN_ALPHA + gv[bj][n] * acc[ai][bj][m][n];
                    }
                if (m & 1) asm volatile("" ::: "memory");
            }
    }
};
__device__ __forceinline__ void store8(bf16_t* p, const f32x4& a, const f32x4& b) {
    u32x4 w; w.x = pk2(a[0], a[1]); w.y = pk2(a[2], a[3]); w.z = pk2(b[0], b[1]); w.w = pk2(b[2], b[3]);
    *(u32x4*)p = w;
}
struct EpiGla {
    static constexpr bool PERM = true;
    bf16_t *Q, *Kk, *V, *R; float* GLR;
    __device__ __forceinline__ void operator()(const f32x4 (&acc)[2][2][4][2], const pg8::Unit& u, int wr, int wc, int fr, int fq) const {
        const int row0 = u.pm * 256 + wr * 64 + fr;
        if (u.pn < 24) {
            bf16_t* base; int ldc, colt;
            if (u.pn < 4) { base = Q; ldc = 1024; colt = u.pn * 256; }
            else if (u.pn < 8) { base = Kk; ldc = 1024; colt = (u.pn - 4) * 256; }
            else if (u.pn < 16) { base = V; ldc = 2048; colt = (u.pn - 8) * 256; }
            else { base = R; ldc = 2048; colt = (u.pn - 16) * 256; }
            const int col0 = colt + wc * 32 + 8 * fq;
#pragma unroll
            for (int ai = 0; ai < 2; ++ai)
#pragma unroll
                for (int m = 0; m < 4; ++m) {
                    bf16_t* rowp = base + (size_t)(row0 + ai * 128 + m * 16) * ldc + col0;
#pragma unroll
                    for (int bj = 0; bj < 2; ++bj) store8(rowp + bj * 128, acc[ai][bj][m][0], acc[ai][bj][m][1]);
                }
        } else if (wc == 0 && fq < 2) {
#pragma unroll
            for (int ai = 0; ai < 2; ++ai)
#pragma unroll
                for (int m = 0; m < 4; ++m) {
                    float* rowp = GLR + (size_t)(row0 + ai * 128 + m * 16) * 16 + 8 * fq;
                    *(f32x4*)rowp = acc[ai][0][m][0]; *(f32x4*)(rowp + 4) = acc[ai][0][m][1];
                }
        }
    }
};
struct EpiDil {
    static constexpr bool PERM = true;
    bf16_t *DQ, *DK, *DV; const float* cosT; const float* sinT;
    __device__ __forceinline__ void operator()(const f32x4 (&acc)[2][2][4][2], const pg8::Unit& u, int wr, int wc, int fr, int fq) const {
        const int row0 = u.pm * 256 + wr * 64 + fr;
        const int seg = u.pn / 12, colt = (u.pn - seg * 12) * 256;
        bf16_t* base = DQ + (size_t)seg * ((size_t)TH * 3072);
        const int col0 = colt + wc * 32 + 8 * fq;
        if (seg == 2) {
#pragma unroll
            for (int ai = 0; ai < 2; ++ai)
#pragma unroll
                for (int m = 0; m < 4; ++m) {
                    bf16_t* rowp = base + (size_t)(row0 + ai * 128 + m * 16) * 3072 + col0;
#pragma unroll
                    for (int bj = 0; bj < 2; ++bj) store8(rowp + bj * 128, acc[ai][bj][m][0], acc[ai][bj][m][1]);
                }
        } else {
            const float sc = seg == 0 ? 0.08838834764831845f : 1.0f;
            const int g4 = 4 * (4 * wc + fq);
#pragma unroll
            for (int ai = 0; ai < 2; ++ai)
#pragma unroll
                for (int m = 0; m < 4; ++m) {
                    const int row = row0 + ai * 128 + m * 16;
                    const f32x4 c4 = *(const f32x4*)(cosT + (size_t)row * 64 + g4) * sc, s4 = *(const f32x4*)(sinT + (size_t)row * 64 + g4) * sc;
                    bf16_t* rowp = base + (size_t)row * 3072 + col0;
#pragma unroll
                    for (int bj = 0; bj < 2; ++bj) {
                        const f32x4 x1 = acc[ai][bj][m][0], x2 = acc[ai][bj][m][1];
                        store8(rowp + bj * 128, x1 * c4 - x2 * s4, x2 * c4 + x1 * s4);
                    }
                    asm volatile("" ::: "memory");
                }
        }
    }
};
struct EpiGates {
    static constexpr bool PERM = true;
    bf16_t *SGA, *SGB;
    __device__ __forceinline__ void operator()(const f32x4 (&acc)[2][2][4][2], const pg8::Unit& u, int wr, int wc, int fr, int fq) const {
        const int row0 = u.pm * 256 + wr * 64 + fr;
        bf16_t* base = u.pn < 8 ? SGA : SGB;
        const int col0 = (u.pn & 7) * 256 + wc * 32 + 8 * fq;
#pragma unroll
        for (int ai = 0; ai < 2; ++ai)
#pragma unroll
            for (int m = 0; m < 4; ++m) {
                bf16_t* rowp = base + (size_t)(row0 + ai * 128 + m * 16) * D + col0;
#pragma unroll
                for (int bj = 0; bj < 2; ++bj) {
                    f32x4 a = acc[ai][bj][m][0], b = acc[ai][bj][m][1];
#pragma unroll
                    for (int j = 0; j < 4; ++j) { a[j] = sigmoidf_(a[j]); b[j] = sigmoidf_(b[j]); }
                    store8(rowp + bj * 128, a, b);
                }
            }
    }
};
template <bool ADD> struct EpiMul {
    static constexpr bool PERM = true;
    const bf16_t* gate; bf16_t* io;
    __device__ __forceinline__ void operator()(const f32x4 (&acc)[2][2][4][2], const pg8::Unit& u, int wr, int wc, int fr, int fq) const {
        const int row0 = u.pm * 256 + wr * 64 + fr, col0 = u.pn * 256 + wc * 32 + 8 * fq;
#pragma unroll
        for (int ai = 0; ai < 2; ++ai)
#pragma unroll
            for (int m = 0; m < 4; ++m) {
                const size_t off = (size_t)(row0 + ai * 128 + m * 16) * D + col0;
#pragma unroll
                for (int bj = 0; bj < 2; ++bj) {
                    const u32x4 gw = *(const u32x4*)(gate + off + bj * 128);
                    f32x4 a = acc[ai][bj][m][0], b = acc[ai][bj][m][1];
                    a[0] *= bf_lo(gw.x); a[1] *= bf_hi(gw.x); a[2] *= bf_lo(gw.y); a[3] *= bf_hi(gw.y);
                    b[0] *= bf_lo(gw.z); b[1] *= bf_hi(gw.z); b[2] *= bf_lo(gw.w); b[3] *= bf_hi(gw.w);
                    if (ADD) {
                        const u32x4 tw = *(const u32x4*)(io + off + bj * 128);
                        a[0] += bf_lo(tw.x); a[1] += bf_hi(tw.x); a[2] += bf_lo(tw.y); a[3] += bf_hi(tw.y);
                        b[0] += bf_lo(tw.z); b[1] += bf_hi(tw.z); b[2] += bf_lo(tw.w); b[3] += bf_hi(tw.w);
                    }
                    store8(io + off + bj * 128, a, b);
                }
            }
    }
};

__device__ __forceinline__ void mods_item(CArgs a, float* mods, LAS float* scr, int item, int lane) {
    const int cg_ = item % 72, kc = item / 72, k0 = kc * 128, col = cg_ * 256 + 4 * lane;
#pragma unroll
    for (int i = 0; i < 8; ++i) { const int e = lane + 64 * i, b = e >> 7, kk = e & 127; scr[e] = siluf_(a->c[b * D + k0 + kk]); }
    asm volatile("s_waitcnt lgkmcnt(0)" ::: "memory");
    f32x4 s0 = {0, 0, 0, 0}, s1 = s0, s2 = s0, s3 = s0;
    const float* wp = a->w_ada + (size_t)k0 * (NMOD * D) + col;
#pragma unroll 8
    for (int kk = 0; kk < 128; ++kk) {
        const f32x4 w = *(const f32x4*)(wp + (size_t)kk * (NMOD * D));
        s0 += w * scr[kk]; s1 += w * scr[128 + kk]; s2 += w * scr[256 + kk]; s3 += w * scr[384 + kk];
    }
    if (kc == 0) { const f32x4 bb = *(const f32x4*)(a->b_ada + col); s0 += bb; s1 += bb; s2 += bb; s3 += bb; }
#pragma unroll
    for (int j = 0; j < 4; ++j) {
        atomicAdd(mods + 0 * NMOD * D + col + j, s0[j]); atomicAdd(mods + 1 * NMOD * D + col + j, s1[j]);
        atomicAdd(mods + 2 * NMOD * D + col + j, s2[j]); atomicAdd(mods + 3 * NMOD * D + col + j, s3[j]);
    }
    asm volatile("s_waitcnt lgkmcnt(0)" ::: "memory");
}
__device__ __forceinline__ int srccol(int mode, int n, int src0) {
    if (mode == 0) return src0 + n;
    if (mode == 1) { const int head = n >> 7, p = n & 127, g = p >> 3, nn = (p >> 2) & 1, j = p & 3; return src0 + head * 128 + 4 * g + j + 64 * nn; }
    const int pn = n >> 8, rr = n & 255; return rr < 128 ? pn * 128 + rr : FF + pn * 128 + rr - 128;
}
__device__ __forceinline__ void transpose_item(const float* W, int K, int N, bf16_t* WT, int dst0, int src0, int mode, int nblk, LAS float* scr, int item, int lane) {
    const int kb = item / nblk, nb = item % nblk, k0 = 64 * kb, n0 = 32 * nb;
    const int sc = srccol(mode, n0 + (lane & 31), src0);
#pragma unroll 8
    for (int i = 0; i < 32; ++i) { const int kk = 2 * i + (lane >> 5); scr[kk * 33 + (lane & 31)] = W[(size_t)(k0 + kk) * N + sc]; }
    asm volatile("s_waitcnt lgkmcnt(0)" ::: "memory");
    const int c = lane & 7;
#pragma unroll
    for (int j = 0; j < 4; ++j) { const int n = (lane >> 3) + 8 * j; const LAS float* s = scr + (8 * c) * 33 + n;
        u32x4 o; o.x = pk2(s[0 * 33], s[1 * 33]); o.y = pk2(s[2 * 33], s[3 * 33]); o.z = pk2(s[4 * 33], s[5 * 33]); o.w = pk2(s[6 * 33], s[7 * 33]);
        *(u32x4*)(WT + (size_t)(dst0 + n0 + n) * K + k0 + 8 * c) = o; }
    asm volatile("s_waitcnt lgkmcnt(0)" ::: "memory");
}
__device__ __forceinline__ bool tj(const float* W, int K, int N, bf16_t* WT, int dst0, int nrows, int src0, int mode, int& r, LAS float* scr, int lane) {
    const int cnt = (K / 64) * (nrows / 32);
    if (r < cnt) { transpose_item(W, K, N, WT, dst0, src0, mode, nrows / 32, scr, r, lane); return true; }
    r -= cnt; return false;
}

__device__ __forceinline__ void modulate_rows(const float* x, const float* mods, int ch_shift, bf16_t* h, int gw, int NGW, int lane) {
    for (int m = gw; m < T; m += NGW) {
        const float* mp = mods + (size_t)(m / SEQ) * (NMOD * D) + ch_shift * D;
        const f32x4* xr = (const f32x4*)(x + (size_t)m * D) + lane;
        u32x2* o8 = (u32x2*)(h + (size_t)m * D) + lane;
#pragma unroll
        for (int j = 0; j < 8; ++j) {
            const f32x4 v = xr[64 * j], sh = ((const f32x4*)mp)[lane + 64 * j], sc = ((const f32x4*)(mp + D))[lane + 64 * j];
            const f32x4 r = v * (sc + 1.0f) + sh;
            u32x2 w; w.x = pk2(r[0], r[1]); w.y = pk2(r[2], r[3]); o8[64 * j] = w;
        }
    }
}
__device__ __forceinline__ void ln_rows(float* y, const float* g, const float* bta, const float* mods, int ch_shift, bf16_t* h, int gw, int NGW, int lane) {
    for (int m = gw; m < T; m += NGW) {
        f32x4* yr = (f32x4*)(y + (size_t)m * D) + lane;
        f32x4 v[8]; float s = 0.f;
#pragma unroll
        for (int j = 0; j < 8; ++j) { v[j] = yr[64 * j]; s += (v[j][0] + v[j][1]) + (v[j][2] + v[j][3]); }
        const float mean = wave_sum(s) * (1.f / D); float s2 = 0.f;
#pragma unroll
        for (int j = 0; j < 8; ++j) { v[j] = v[j] - mean; s2 += (v[j][0] * v[j][0] + v[j][1] * v[j][1]) + (v[j][2] * v[j][2] + v[j][3] * v[j][3]); }
        const float rstd = 1.f / sqrtf(wave_sum(s2) * (1.f / D) + LN_EPS);
#pragma unroll
        for (int j = 0; j < 8; ++j) {
            const f32x4 gg = ((const f32x4*)g)[lane + 64 * j], bb = ((const f32x4*)bta)[lane + 64 * j];
            v[j] = v[j] * rstd * gg + bb; yr[64 * j] = v[j];
        }
        if (h) {
            const float* mp = mods + (size_t)(m / SEQ) * (NMOD * D) + ch_shift * D;
            u32x2* o8 = (u32x2*)(h + (size_t)m * D) + lane;
#pragma unroll
            for (int j = 0; j < 8; ++j) {
                const f32x4 sh = ((const f32x4*)mp)[lane + 64 * j], sc = ((const f32x4*)(mp + D))[lane + 64 * j];
                const f32x4 r = v[j] * (sc + 1.0f) + sh;
                u32x2 w; w.x = pk2(r[0], r[1]); w.y = pk2(r[2], r[3]); o8[64 * j] = w;
            }
        }
    }
}

constexpr int GP = 264;
constexpr int VP = 72;
__device__ __forceinline__ void gla_prep(CArgs a, LAS unsigned char* lds) {
    unsigned char* ws = a->ws;
    bf16_t* Q = (bf16_t*)(ws + WS_Q); bf16_t* Kk = (bf16_t*)(ws + WS_K); const float* GLR = (const float*)(ws + WS_GLR);
    bf16_t* AIN = (bf16_t*)(ws + WS_AIN); float* DEC = (float*)(ws + WS_DEC);
    const int tid = tid_local(), lane = tid & 63, wid = __builtin_amdgcn_readfirstlane(tid >> 6), fr = lane & 15, fq = lane >> 4;
    LAS unsigned char* Qd = lds; LAS unsigned char* Ki = lds + 64 * GP * 2; LAS float* tot = (LAS float*)(lds + 2 * 64 * GP * 2);
    const int dk = tid & 255, half = __builtin_amdgcn_readfirstlane(tid >> 8);
    for (int unit = blockIdx.x; unit < NB * 4 * 128; unit += gridDim.x) {
        const int c = unit & 127, bh = unit >> 7, h = bh & 3, b = bh >> 2;
        const int t0 = b * SEQ + c * 64;
        LAS float* glr_l = (LAS float*)(lds + 2 * 64 * GP * 2 + 2048);
        if (tid < 256) *(LAS f32x4*)(glr_l + tid * 4) = *(const f32x4*)(GLR + (size_t)t0 * 16 + tid * 4);
        float w2[16];
#pragma unroll
        for (int r = 0; r < 16; ++r) w2[r] = a->w_alpha2[r * 1024 + h * 256 + dk];
        const float ba = a->b_alpha[h * 256 + dk];
        float la[32], qv[32], kv[32]; float run = 0.f;
#pragma unroll
        for (int i = 0; i < 32; ++i) {
            const size_t gi = (size_t)(t0 + half * 32 + i) * 1024 + h * 256 + dk;
            qv[i] = bf2f(Q[gi]); kv[i] = bf2f(Kk[gi]);
        }
        __syncthreads();
#pragma unroll
        for (int i = 0; i < 32; ++i) {
            const LAS f32x4* gp = (const LAS f32x4*)(glr_l + (half * 32 + i) * 16);
            const f32x4 g0 = gp[0], g1 = gp[1], g2 = gp[2], g3 = gp[3];
            float z = ba;
#pragma unroll
            for (int j = 0; j < 4; ++j) { z += g0[j] * w2[j]; z += g1[j] * w2[4 + j]; z += g2[j] * w2[8 + j]; z += g3[j] * w2[12 + j]; }
            const float ls = fminf(z, 0.f) - __logf(1.0f + __expf(-fabsf(z)));
            run += ls * (1.0f / 16.0f); la[i] = run;
        }
        tot[half * 256 + dk] = run;
        __syncthreads();
        const float t0s = tot[dk], t1s = tot[256 + dk];
        const float boff = half ? t0s : 0.f, blast = t0s + t1s, eblast = __expf(blast);
        if (half == 0) DEC[(size_t)unit * 256 + dk] = eblast;
        unsigned kew[16]; float kef_prev = 0.f;
#pragma unroll
        for (int i = 0; i < 32; ++i) {
            const int s = half * 32 + i;
            const float eb = __expf(boff + la[i]);
            const float kif = kv[i] * fast_rcp(eb);
            const bf16_t qd = f2bf(qv[i] * eb * 0.0625f), ki = f2bf(kif);
            *(LAS bf16_t*)(Qd + (s * GP + dk) * 2) = qd; *(LAS bf16_t*)(Ki + (s * GP + dk) * 2) = ki;
            const float kef = kif * eblast;
            if (i & 1) kew[i >> 1] = pk2(kef_prev, kef);
            kef_prev = kef;
        }
        {
            const int jj = (dk >> 4) * 2 + half;
#pragma unroll
            for (int v = 0; v < 4; ++v) { const int l = v * 16 + (dk & 15);
                *(u32x4*)(Kk + (size_t)(t0 + 2 * jj + (l >> 5)) * 1024 + h * 256 + (l & 31) * 8) = (u32x4){kew[4 * v], kew[4 * v + 1], kew[4 * v + 2], kew[4 * v + 3]}; }
        }
        __syncthreads();
#pragma unroll
        for (int i = 0; i < 4; ++i) { const int id = tid + 512 * i, j = id >> 6, l = id & 63;
            const u32x4 w = *(const LAS u32x4*)(Qd + ((16 * (j >> 3) + (l & 15)) * GP + 32 * (j & 7) + 8 * (l >> 4)) * 2);
            *(u32x4*)(Q + (size_t)(t0 + 2 * j + (l >> 5)) * 1024 + h * 256 + (l & 31) * 8) = w; }
        const int rt = wid >> 1, ct0 = (wid & 1) * 2;
        f32x4 o[2] = {{0, 0, 0, 0}, {0, 0, 0, 0}};
#pragma unroll
        for (int kk = 0; kk < 8; ++kk) {
            const bf16x8 af = *(const LAS bf16x8*)(Qd + ((16 * rt + fr) * GP + 32 * kk + 8 * fq) * 2);
#pragma unroll
            for (int c2 = 0; c2 < 2; ++c2) {
                const bf16x8 bfr = *(const LAS bf16x8*)(Ki + ((16 * (ct0 + c2) + fr) * GP + 32 * kk + 8 * fq) * 2);
                o[c2] = MFMA16(af, bfr, o[c2]);
            }
        }
#pragma unroll
        for (int c2 = 0; c2 < 2; ++c2)
#pragma unroll
            for (int j = 0; j < 4; ++j) {
                const int s = 16 * rt + 4 * fq + j, sp = 16 * (ct0 + c2) + fr;
                AIN[(size_t)unit * 4096 + (((rt * 2 + (sp >> 5)) * 64 + ((sp & 31) >> 3) * 16 + (s & 15)) << 3) + (sp & 7)] = f2bf(sp <= s ? o[c2][j] : 0.f);
            }
        __syncthreads();
    }
}
__device__ __forceinline__ void gla_seq(CArgs a, LAS unsigned char* lds) {
    const int blk = blockIdx.x; if (blk >= 128) return;
    unsigned char* ws = a->ws;
    const bf16_t* Q = (const bf16_t*)(ws + WS_Q); const bf16_t* Kk = (const bf16_t*)(ws + WS_K); const bf16_t* V = (const bf16_t*)(ws + WS_V);
    const bf16_t* AIN = (const bf16_t*)(ws + WS_AIN); const float* DEC = (const float*)(ws + WS_DEC); float* ORAW = (float*)(ws + WS_ORAW);
    const int bh = (blk & 7) + 8 * (blk >> 6), dvs = (blk >> 3) & 7, b = bh >> 2, h = bh & 3;
    const int tid = tid_local(), lane = tid & 63, wid = __builtin_amdgcn_readfirstlane(tid >> 6), fr = lane & 15, fq = lane >> 4, qq = fr >> 2, pp = lane & 3;
    constexpr int VB = 64 * VP * 2, SBB = 64 * GP * 2;
    LAS unsigned char* Vl = lds; LAS unsigned char* Sb = lds + 2 * VB;
    for (int e = tid; e < SBB / 16; e += 512) *(LAS u32x4*)(Sb + SBB + e * 16) = (u32x4){0, 0, 0, 0};
    f32x4 S[2][4];
#pragma unroll
    for (int r2 = 0; r2 < 2; ++r2)
#pragma unroll
        for (int ct = 0; ct < 4; ++ct) S[r2][ct] = (f32x4){0, 0, 0, 0};
    const int unit0 = bh * 128, vrow = tid >> 3, vch = tid & 7, rt = wid >> 1, ct0 = (wid & 1) * 2;
    const int dk0 = 16 * (2 * wid) + fr, dk1 = dk0 + 16;
    const size_t fragoff = (size_t)(lane >> 5) * 1024 + h * 256 + (lane & 31) * 8;
    const size_t voff = (size_t)vrow * 2048 + h * 512 + dvs * 64 + vch * 8;
    const int doff = 16 * (2 * wid) + 4 * fq;
    bf16x8 nq[8], na[2], nk[2][2]; f32x4 nd[2]; u32x4 nv;
#define GLA_LOAD(c) do { const size_t tb_ = (size_t)(b * SEQ + (c) * 64); const size_t ub_ = (size_t)(unit0 + (c)); \
        _Pragma("unroll") for (int kk = 0; kk < 8; ++kk) nq[kk] = *(const bf16x8*)(Q + (tb_ + 2 * (rt * 8 + kk)) * 1024 + fragoff); \
        _Pragma("unroll") for (int kk = 0; kk < 2; ++kk) { na[kk] = *(const bf16x8*)(AIN + ub_ * 4096 + ((rt * 2 + kk) * 64 + lane) * 8); \
            nk[0][kk] = *(const bf16x8*)(Kk + (tb_ + 2 * ((2 * wid) * 2 + kk)) * 1024 + fragoff); nk[1][kk] = *(const bf16x8*)(Kk + (tb_ + 2 * ((2 * wid + 1) * 2 + kk)) * 1024 + fragoff); } \
        nd[0] = *(const f32x4*)(DEC + ub_ * 256 + doff); nd[1] = *(const f32x4*)(DEC + ub_ * 256 + doff + 16); } while (0)
    nv = *(const u32x4*)(V + (size_t)(b * SEQ) * 2048 + voff);
    GLA_LOAD(0);
    *(LAS u32x4*)(Vl + (vrow * VP + vch * 8) * 2) = nv;
    __syncthreads();
    for (int c = 0; c < 128; ++c) {
        const int pb = c & 1;
        bf16x8 cq[8], ca[2], ck[2][2]; f32x4 cd[2];
#pragma unroll
        for (int kk = 0; kk < 8; ++kk) cq[kk] = nq[kk];
#pragma unroll
        for (int kk = 0; kk < 2; ++kk) { ca[kk] = na[kk]; ck[0][kk] = nk[0][kk]; ck[1][kk] = nk[1][kk]; }
        cd[0] = nd[0]; cd[1] = nd[1];
        if (c + 1 < 128) { nv = *(const u32x4*)(V + (size_t)(b * SEQ + (c + 1) * 64) * 2048 + voff); GLA_LOAD(c + 1); }
        const LAS unsigned char* Vc = Vl + pb * VB; const LAS unsigned char* Sp = Sb + (pb ^ 1) * SBB;
        {
            f32x4 o[2] = {{0, 0, 0, 0}, {0, 0, 0, 0}};
#pragma unroll
            for (int kk = 0; kk < 2; ++kk)
#pragma unroll
                for (int c2 = 0; c2 < 2; ++c2) {
                    const LAS unsigned char* vp = Vc + ((32 * kk + 8 * fq + qq) * VP + 16 * (ct0 + c2) + 4 * pp) * 2;
                    o[c2] = MFMA16(cat8(tr4(vp), tr4(vp + 4 * VP * 2)), ca[kk], o[c2]);
                }
#pragma unroll
            for (int kk = 0; kk < 8; ++kk)
#pragma unroll
                for (int c2 = 0; c2 < 2; ++c2) {
                    const bf16x8 bfr = *(const LAS bf16x8*)(Sp + ((16 * (ct0 + c2) + fr) * GP + 32 * kk + 8 * fq) * 2);
                    o[c2] = MFMA16(bfr, cq[kk], o[c2]);
                }
            const int t0 = b * SEQ + c * 64;
#pragma unroll
            for (int c2 = 0; c2 < 2; ++c2)
                *(f32x4*)(ORAW + (size_t)(t0 + 16 * rt + fr) * 2048 + h * 512 + dvs * 64 + 16 * (ct0 + c2) + 4 * fq) = o[c2];
        }
        {
#pragma unroll
            for (int r2 = 0; r2 < 2; ++r2)
#pragma unroll
                for (int ct = 0; ct < 4; ++ct) S[r2][ct] = S[r2][ct] * cd[r2];
#pragma unroll
            for (int kk = 0; kk < 2; ++kk)
#pragma unroll
                for (int ct = 0; ct < 4; ++ct) {
                    const LAS unsigned char* vp = Vc + ((32 * kk + 8 * fq + qq) * VP + 16 * ct + 4 * pp) * 2;
                    const bf16x8 bfr = cat8(tr4(vp), tr4(vp + 4 * VP * 2));
#pragma unroll
                    for (int r2 = 0; r2 < 2; ++r2) S[r2][ct] = MFMA16(ck[r2][kk], bfr, S[r2][ct]);
                }
        }
        LAS unsigned char* Sn = Sb + pb * SBB;
#pragma unroll
        for (int r2 = 0; r2 < 2; ++r2)
#pragma unroll
            for (int ct = 0; ct < 4; ++ct) {
                u32x2 w; w.x = pk2(S[r2][ct][0], S[r2][ct][1]); w.y = pk2(S[r2][ct][2], S[r2][ct][3]);
                *(LAS u32x2*)(Sn + ((16 * ct + fr) * GP + 16 * (2 * wid + r2) + 4 * fq) * 2) = w;
            }
        if (c + 1 < 128) *(LAS u32x4*)(Vl + (pb ^ 1) * VB + (vrow * VP + vch * 8) * 2) = nv;
        __syncthreads();
    }
#undef GLA_LOAD
}
__device__ __forceinline__ void gla_norm(CArgs a, int gw, int NGW, int lane) {
    unsigned char* ws = a->ws;
    const float* ORAW = (const float*)(ws + WS_ORAW); const bf16_t* R = (const bf16_t*)(ws + WS_R); bf16_t* OA = (bf16_t*)(ws + WS_OA);
    for (int m = gw; m < T; m += NGW) {
        const f32x4* orow = (const f32x4*)(ORAW + (size_t)m * 2048) + lane;
        const u32x2* rrow = (const u32x2*)(R + (size_t)m * 2048) + lane;
        u32x2* out = (u32x2*)(OA + (size_t)m * 2048) + lane;
        f32x4 v[8];
#pragma unroll
        for (int j = 0; j < 8; ++j) v[j] = orow[64 * j];
#pragma unroll
        for (int hh = 0; hh < 4; ++hh) {
            const f32x4 x0 = v[2 * hh], x1 = v[2 * hh + 1];
            float s = (x0[0] * x0[0] + x0[1] * x0[1]) + (x0[2] * x0[2] + x0[3] * x0[3]) + (x1[0] * x1[0] + x1[1] * x1[1]) + (x1[2] * x1[2] + x1[3] * x1[3]);
            const float rs = 1.0f / sqrtf(wave_sum(s) * (1.0f / 512.0f) + LN_EPS);
#pragma unroll
            for (int jj = 0; jj < 2; ++jj) {
                const int j = 2 * hh + jj;
                const f32x4 gg = ((const f32x4*)a->gla_g)[lane + 64 * j];
                const u32x2 rw = rrow[64 * j];
                const float r0 = bf_lo(rw.x), r1 = bf_hi(rw.x), r2 = bf_lo(rw.y), r3 = bf_hi(rw.y);
                const f32x4 x = v[j] * rs * gg;
                u32x2 w; w.x = pk2(x[0] * siluf_(r0), x[1] * siluf_(r1)); w.y = pk2(x[2] * siluf_(r2), x[3] * siluf_(r3));
                out[64 * j] = w;
            }
        }
    }
}
__device__ __forceinline__ void rope_tables(CArgs a) {
    float* cosT = (float*)(a->ws + WS_COS); float* sinT = (float*)(a->ws + WS_SIN);
    const size_t n = (size_t)T * 64;
    for (size_t e = (size_t)blockIdx.x * 512 + threadIdx.x; e < n; e += (size_t)gridDim.x * 512) {
        const int t = (int)(e >> 6), i = (int)(e & 63);
        const float fr = (float)exp2(-(double)i * (13.287712379549449 / 64.0));
        const float pos = (float)a->pos[t];
        const float ang = pos * fr;
        double rev = (double)ang * 0.15915494309189535; rev -= floor(rev);
        const float rv = (float)rev;
        cosT[e] = __builtin_amdgcn_cosf(rv); sinT[e] = __builtin_amdgcn_sinf(rv);
    }
}

constexpr int KP = 136;
__device__ __forceinline__ void dil_attn(CArgs a, LAS unsigned char* lds) {
    unsigned char* ws = a->ws;
    const bf16_t* DQ = (const bf16_t*)(ws + WS_DQ); const bf16_t* DK = (const bf16_t*)(ws + WS_DK); const bf16_t* DV = (const bf16_t*)(ws + WS_DV);
    bf16_t* OG = (bf16_t*)(ws + WS_OG); float* LSE = (float*)(ws + WS_LSE);
    const int tid = tid_local(), lane = tid & 63, wid = tid >> 6  , fr = lane & 15, fq = lane >> 4, qq = fr >> 2, pp = lane & 3;
    LAS unsigned char* Kt = lds; LAS unsigned char* Vt = lds + 256 * KP * 2;
    const int vcu = (gridDim.x & 7) == 0 ? (int)((blockIdx.x & 7) * (gridDim.x >> 3) + (blockIdx.x >> 3)) : (int)blockIdx.x;
    for (int unit = vcu; unit < 2 * 3 * 8 * 64; unit += gridDim.x) {
        const int u64 = unit & 63, hh = (unit >> 6) & 7, g = (unit >> 9) % 3, bl = unit / 1536;
        const int r = 1 << (2 * g), nb = 64 >> (2 * g), rc = u64 / nb, n = u64 % nb;
        const int tb = bl * SEQ, cb = g * 1024 + hh * 128;
        {
            const int ch = tid & 15, r0 = tid >> 4;
            const bool hasprev = n > 0;
            const size_t rowstep = (size_t)32 * r * 3072;
            const bf16_t* kp = DK + (size_t)(tb + (128 * (n - 1) + r0) * r + rc) * 3072 + cb + ch * 8;
            const bf16_t* vp = DV + (size_t)(tb + (128 * (n - 1) + r0) * r + rc) * 3072 + cb + ch * 8;
            u32x4 kr[8];
#pragma unroll
            for (int i = 0; i < 4; ++i) kr[i] = (u32x4){0, 0, 0, 0};
            if (hasprev) {
#pragma unroll
                for (int i = 0; i < 4; ++i) kr[i] = *(const u32x4*)(kp + i * rowstep);
            }
#pragma unroll
            for (int i = 4; i < 8; ++i) kr[i] = *(const u32x4*)(kp + i * rowstep);
#pragma unroll
            for (int i = 0; i < 8; ++i) *(LAS u32x4*)(Kt + ((r0 + 32 * i) * KP + ch * 8) * 2) = kr[i];
#pragma unroll
            for (int i = 0; i < 4; ++i) kr[i] = (u32x4){0, 0, 0, 0};
            if (hasprev) {
#pragma unroll
                for (int i = 0; i < 4; ++i) kr[i] = *(const u32x4*)(vp + i * rowstep);
            }
#pragma unroll
            for (int i = 4; i < 8; ++i) kr[i] = *(const u32x4*)(vp + i * rowstep);
#pragma unroll
            for (int i = 0; i < 8; ++i) *(LAS u32x4*)(Vt + ((r0 + 32 * i) * KP + ch * 8) * 2) = kr[i];
        }
        bf16x8 qf[4];
        { const size_t tq = (size_t)(tb + (128 * n + 16 * wid + fr) * r + rc);
#pragma unroll
          for (int kk = 0; kk < 4; ++kk) qf[kk] = *(const bf16x8*)(DQ + tq * 3072 + cb + 32 * kk + 8 * fq); }
        __syncthreads();
        f32x4 sc[10];
#pragma unroll
        for (int i = 0; i < 10; ++i) {
            const int kt = wid + i, ktc = kt < 15 ? kt : 15;
            f32x4 acc = {0, 0, 0, 0};
#pragma unroll
            for (int kk = 0; kk < 4; ++kk) {
                const bf16x8 af = *(const LAS bf16x8*)(Kt + ((16 * ktc + fr) * KP + 32 * kk + 8 * fq) * 2);
                acc = MFMA16(af, qf[kk], acc);
            }
            sc[i] = acc;
        }
        const int qi = 16 * wid + fr;
        const int klo = (n > 0 || qi >= 128) ? qi : 128, khi = qi + 128 < 255 ? qi + 128 : 255;
        float mx = -3.0e38f;
#pragma unroll
        for (int i = 0; i < 10; ++i)
#pragma unroll
            for (int j = 0; j < 4; ++j) {
                const int kj = 16 * (wid + i) + 4 * fq + j;
                const int dlo = kj - klo, dhi = khi - kj;
                const int dm = (dlo < dhi ? dlo : dhi) >> 31;
                sc[i][j] = fmaf((float)dm, 3.0e38f, sc[i][j]);
                mx = fmaxf(mx, sc[i][j]);
            }
        mx = fmaxf(mx, __shfl_xor(mx, 16)); mx = fmaxf(mx, __shfl_xor(mx, 32));
        float den = 0.f;
#pragma unroll
        for (int i = 0; i < 10; ++i)
#pragma unroll
            for (int j = 0; j < 4; ++j) { const float p = __expf(sc[i][j] - mx); sc[i][j] = p; den += p; }
        den += __shfl_xor(den, 16); den += __shfl_xor(den, 32);
        f32x4 o[8];
#pragma unroll
        for (int dt = 0; dt < 8; ++dt) o[dt] = (f32x4){0, 0, 0, 0};
#pragma unroll
        for (int pi = 0; pi < 5; ++pi) {
            const int kta = wid + 2 * pi, ktb = kta + 1, ka = kta < 15 ? kta : 15, kb = ktb < 15 ? ktb : 15;
            bf16x8 pf;
            { const unsigned w0 = pk2(sc[2 * pi][0], sc[2 * pi][1]), w1 = pk2(sc[2 * pi][2], sc[2 * pi][3]), w2 = pk2(sc[2 * pi + 1][0], sc[2 * pi + 1][1]), w3 = pk2(sc[2 * pi + 1][2], sc[2 * pi + 1][3]);
              pf = __builtin_bit_cast(bf16x8, (u32x4){w0, w1, w2, w3}); }
#pragma unroll
            for (int dt = 0; dt < 8; ++dt) {
                const LAS unsigned char* va = Vt + ((16 * ka + 4 * fq + qq) * KP + 16 * dt + 4 * pp) * 2;
                const LAS unsigned char* vb = Vt + ((16 * kb + 4 * fq + qq) * KP + 16 * dt + 4 * pp) * 2;
                const bf16x8 bfr = cat8(tr4(va), tr4(vb));
                o[dt] = MFMA16(pf, bfr, o[dt]);
            }
        }
        const float lse_l = mx + __logf(den);
        if (fq == 0) LSE[(size_t)(tb + (128 * n + qi) * r + rc) * 24 + g * 8 + hh] = lse_l;
#pragma unroll
        for (int j = 0; j < 4; ++j) {
            const float dj = __shfl(den, 4 * fq + j);
            const float inv = fast_rcp(dj);
            const size_t tq = (size_t)(tb + (128 * n + 16 * wid + 4 * fq + j) * r + rc);
#pragma unroll
            for (int dt = 0; dt < 8; ++dt) OG[tq * 3072 + cb + 16 * dt + fr] = f2bf(o[dt][j] * inv);
        }
        __syncthreads();
    }
}
__device__ __forceinline__ void dil_merge(CArgs a, int half, int gw, int NGW, int lane) {
    const bf16_t* OG = (const bf16_t*)(a->ws + WS_OG); const float* LSE = (const float*)(a->ws + WS_LSE); bf16_t* OB = (bf16_t*)(a->ws + WS_OB);
    const int hh = lane >> 3, d0 = (lane & 7) * 16;
    for (int m = gw; m < TH; m += NGW) {
        const float l0 = LSE[(size_t)m * 24 + hh], l1 = LSE[(size_t)m * 24 + 8 + hh], l2 = LSE[(size_t)m * 24 + 16 + hh];
        const float mx = fmaxf(l0, fmaxf(l1, l2));
        float w0 = __expf(l0 - mx), w1 = __expf(l1 - mx), w2 = __expf(l2 - mx);
        const float inv = 1.0f / (w0 + w1 + w2); w0 *= inv; w1 *= inv; w2 *= inv;
        const bf16_t* p = OG + (size_t)m * 3072 + hh * 128 + d0;
        bf16_t* o = OB + (size_t)(half * TH + m) * 1024 + hh * 128 + d0;
#pragma unroll
        for (int q = 0; q < 2; ++q) {
            const u32x4 a0 = *(const u32x4*)(p + 8 * q), a1 = *(const u32x4*)(p + 1024 + 8 * q), a2 = *(const u32x4*)(p + 2048 + 8 * q);
            u32x4 w;
            w.x = pk2(w0 * bf_lo(a0.x) + w1 * bf_lo(a1.x) + w2 * bf_lo(a2.x), w0 * bf_hi(a0.x) + w1 * bf_hi(a1.x) + w2 * bf_hi(a2.x));
            w.y = pk2(w0 * bf_lo(a0.y) + w1 * bf_lo(a1.y) + w2 * bf_lo(a2.y), w0 * bf_hi(a0.y) + w1 * bf_hi(a1.y) + w2 * bf_hi(a2.y));
            w.z = pk2(w0 * bf_lo(a0.z) + w1 * bf_lo(a1.z) + w2 * bf_lo(a2.z), w0 * bf_hi(a0.z) + w1 * bf_hi(a1.z) + w2 * bf_hi(a2.z));
            w.w = pk2(w0 * bf_lo(a0.w) + w1 * bf_lo(a1.w) + w2 * bf_lo(a2.w), w0 * bf_hi(a0.w) + w1 * bf_hi(a1.w) + w2 * bf_hi(a2.w));
            *(u32x4*)(o + 8 * q) = w;
        }
    }
}

constexpr size_t WS_BAR = 512 * 1024;
__device__ __forceinline__ void grid_barrier(unsigned* bar, unsigned& gen, unsigned G) {
    asm volatile("s_waitcnt vmcnt(0) lgkmcnt(0)" ::: "memory");
    __syncthreads();
    ++gen;
    if (threadIdx.x == 0) {
        __builtin_amdgcn_fence(__ATOMIC_RELEASE, "agent");
        asm volatile("s_waitcnt vmcnt(0)" ::: "memory");
        if ((G & 7u) == 0u) {
            const unsigned x = blockIdx.x & 7u, per = G >> 3;
            unsigned* cnt1 = bar + 64 * (1 + x); unsigned* cnt2 = bar + 64 * 9; unsigned* rel = bar + 64 * (10 + x);
            const unsigned old = __hip_atomic_fetch_add(cnt1, 1u, __ATOMIC_RELAXED, __HIP_MEMORY_SCOPE_AGENT);
            if (old + 1u == gen * per) {
                __hip_atomic_fetch_add(cnt2, 1u, __ATOMIC_RELAXED, __HIP_MEMORY_SCOPE_AGENT);
                while (__hip_atomic_load(cnt2, __ATOMIC_RELAXED, __HIP_MEMORY_SCOPE_AGENT) < gen * 8u) __builtin_amdgcn_s_sleep(1);
                __hip_atomic_fetch_add(rel, 1u, __ATOMIC_RELAXED, __HIP_MEMORY_SCOPE_AGENT);
            } else {
                while (__hip_atomic_load(rel, __ATOMIC_RELAXED, __HIP_MEMORY_SCOPE_AGENT) < gen) __builtin_amdgcn_s_sleep(1);
            }
        } else {
            __hip_atomic_fetch_add(bar, 1u, __ATOMIC_RELAXED, __HIP_MEMORY_SCOPE_AGENT);
            const unsigned target = gen * G;
            while (__hip_atomic_load(bar, __ATOMIC_RELAXED, __HIP_MEMORY_SCOPE_AGENT) < target) __builtin_amdgcn_s_sleep(2);
        }
        __builtin_amdgcn_fence(__ATOMIC_ACQUIRE, "agent");
        asm volatile("s_waitcnt vmcnt(0)" ::: "memory");
    }
    __syncthreads();
}

#ifndef PH_MASK
#define PH_MASK 0xffffffffu
#endif
#define ON(k) (((PH_MASK) >> (k)) & 1u)
#ifndef GEMM_SP2
#define GEMM_SP2 true
#endif
#ifndef GEMM_ALIGN
#define GEMM_ALIGN true
#endif
__global__ void __launch_bounds__(512, 2) fwd_megakernel(Args a_by_value) {
    extern __shared__ __attribute__((aligned(16))) unsigned char lds_raw[];
    LAS unsigned char* lds = (LAS unsigned char*)lds_raw;
    cg::grid_group grid = cg::this_grid();
    const int tid = tid_local(), lane = tid & 63, wave = __builtin_amdgcn_readfirstlane(tid >> 6);
    const int G = gridDim.x, gw = blockIdx.x * 8 + wave, NGW = G * 8;
    const CArgs ap0 = (CArgs)__builtin_amdgcn_kernarg_segment_ptr();
    LAS float* scr = (LAS float*)(lds + wave * 16384);
#define PH_BEGIN const CArgs a = launder(ap0); unsigned char* const ws = a->ws; float* const mods = (float*)(ws + WS_MODS); (void)mods;
#define Wgu ((bf16_t*)(ws + WS_WGU))
#define Wd ((bf16_t*)(ws + WS_WD))
#define Win ((bf16_t*)(ws + WS_WIN))
#define Wa ((bf16_t*)(ws + WS_WA))
#define Wb ((bf16_t*)(ws + WS_WB))
#define Wo ((bf16_t*)(ws + WS_WO))
#define H ((bf16_t*)(ws + WS_H))
#define ACT ((bf16_t*)(ws + WS_ACT))
    using pg8::Gemm; using pg8::StaticOrder;
    unsigned bar_gen = 0;
    {
        unsigned char* w0 = launder(ap0)->ws;
        const int gid = (int)blockIdx.x * 512 + tid;
        if (gid < (NB * NMOD * D) / 4) ((u32x4*)(w0 + WS_MODS))[gid] = (u32x4){0, 0, 0, 0};
        if (blockIdx.x == 0) for (int i = tid; i < 64 * 20; i += 512) ((unsigned*)(w0 + WS_BAR))[i] = 0u;
        asm volatile("s_waitcnt vmcnt(0)" ::: "memory");
    }
    grid.sync();
#define GRID_SYNC() grid_barrier((unsigned*)(launder(ap0)->ws + WS_BAR), bar_gen, (unsigned)G)

    { PH_BEGIN
    if (ON(0)) for (int it = gw; it < 72 * 16; it += NGW) mods_item(a, mods, scr, it, lane);
    if (ON(0)) {
        constexpr int total = (D / 64) * (2 * FF / 32);
        for (int it = gw; it < total; it += NGW) { int r = it; tj(a->w_gu1, D, 2 * FF, Wgu, 0, 2 * FF, 0, 2, r, scr, lane); }
    }
    }
    GRID_SYNC();
    { PH_BEGIN
    if (ON(1)) modulate_rows(a->x, mods, 0, H, gw, NGW, lane);
    if (ON(1)) {
        constexpr int total = (FF / 64) * (D / 32) + (D / 64) * ((6144 + 32) / 32);
        for (int it = gw; it < total; it += NGW) {
            int r = it;
            if (tj(a->w_d1, FF, D, Wd, 0, D, 0, 0, r, scr, lane)) continue;
            tj(a->w_in, D, WIN_SRC, Win, WR_GLA, 6144 + 32, 0, 0, r, scr, lane);
        }
    }
    }
    GRID_SYNC();
    { PH_BEGIN
    if (ON(2)) { Gemm g{H, Wgu, T, 2 * FF, D}; StaticOrder S; S.init(T, 2 * FF, G, (int)blockIdx.x); EpiGU E{ACT};
      pg8::gemm_phase<EpiGU, StaticOrder, GEMM_ALIGN, GEMM_SP2>(lds, g, S, E); }
    }
    GRID_SYNC();
    { PH_BEGIN
    if (ON(3)) { Gemm g{ACT, Wd, T, D, FF}; StaticOrder S; S.init(T, D, G, (int)blockIdx.x); EpiRes E{a->x, a->out, mods + 2 * D, 0.5f};
      pg8::gemm_phase<EpiRes, StaticOrder, GEMM_ALIGN, GEMM_SP2>(lds, g, S, E); }
    }
    GRID_SYNC();
    { PH_BEGIN
    if (ON(4)) ln_rows(a->out, a->ln1_g, a->ln1_b, mods, 3, H, gw, NGW, lane);
    }
    GRID_SYNC();
    { PH_BEGIN
    if (ON(5)) { Gemm g{H, Win + (size_t)WR_GLA * D, T, 25 * 256, D}; StaticOrder S; S.init(T, 25 * 256, G, (int)blockIdx.x);
      EpiGla E{(bf16_t*)(ws + WS_Q), (bf16_t*)(ws + WS_K), (bf16_t*)(ws + WS_V), (bf16_t*)(ws + WS_R), (float*)(ws + WS_GLR)};
      pg8::gemm_phase<EpiGla, StaticOrder, GEMM_ALIGN, GEMM_SP2>(lds, g, S, E); }
    }
    GRID_SYNC();
    { PH_BEGIN
    if (ON(6)) gla_prep(a, lds);
    }
    GRID_SYNC();
    { PH_BEGIN
    if (ON(7)) {
        if (blockIdx.x < 128) gla_seq(a, lds);
        else {
            const int gw2 = (blockIdx.x - 128) * 8 + wave, NGW2 = (G - 128) * 8;
            constexpr int total = (D / 64) * ((3072 + 3072 + 7168) / 32) + (2048 / 64) * (D / 32) + (1024 / 64) * (D / 32) + (D / 64) * (D / 32) + (D / 64) * (2 * FF / 32) + (FF / 64) * (D / 32);
            for (int it = gw2; it < total; it += NGW2) {
                int r = it;
                if (tj(a->w_in, D, WIN_SRC, Win, WR_DQ, 3072, 6160, 1, r, scr, lane)) continue;
                if (tj(a->w_in, D, WIN_SRC, Win, WR_DK, 3072, 9232, 1, r, scr, lane)) continue;
                if (tj(a->w_in, D, WIN_SRC, Win, WR_DV, 3072 + 4096, 12304, 0, r, scr, lane)) continue;
                if (tj(a->w_a, 2048, D, Wa, 0, D, 0, 0, r, scr, lane)) continue;
                if (tj(a->w_b, 1024, D, Wb, 0, D, 0, 0, r, scr, lane)) continue;
                if (tj(a->w_o, D, D, Wo, 0, D, 0, 0, r, scr, lane)) continue;
                if (tj(a->w_gu2, D, 2 * FF, Wgu, 0, 2 * FF, 0, 2, r, scr, lane)) continue;
                tj(a->w_d2, FF, D, Wd, 0, D, 0, 0, r, scr, lane);
            }
        }
    }
    }
    GRID_SYNC();
    { PH_BEGIN
    if (ON(8)) gla_norm(a, gw, NGW, lane);
    if (ON(9)) rope_tables(a);
    }
    GRID_SYNC();
    for (int half = 0; half < 2; ++half) {
        { PH_BEGIN
        if (ON(11) && half == 1) dil_merge(a, 0, gw, NGW, lane);
        if (ON(9)) { Gemm g{H + (size_t)half * TH * D, Win + (size_t)WR_DQ * D, TH, 36 * 256, D}; StaticOrder S; S.init(TH, 36 * 256, G, (int)blockIdx.x);
          EpiDil E{(bf16_t*)(ws + WS_DQ), (bf16_t*)(ws + WS_DK), (bf16_t*)(ws + WS_DV), (const float*)(ws + WS_COS) + (size_t)half * TH * 64, (const float*)(ws + WS_SIN) + (size_t)half * TH * 64};
          pg8::gemm_phase<EpiDil, StaticOrder, GEMM_ALIGN, GEMM_SP2>(lds, g, S, E); }
        }
        GRID_SYNC();
        { PH_BEGIN
        if (ON(10)) dil_attn(a, lds);
        }
        GRID_SYNC();
    }
    { PH_BEGIN
    if (ON(11)) dil_merge(a, 1, gw, NGW, lane);
    if (ON(13)) { Gemm g{H, Win + (size_t)WR_GATE * D, T, 16 * 256, D}; StaticOrder S; S.init(T, 16 * 256, G, (int)blockIdx.x);
      EpiGates E{(bf16_t*)(ws + WS_SGA), (bf16_t*)(ws + WS_SGB)};
      pg8::gemm_phase<EpiGates, StaticOrder, GEMM_ALIGN, GEMM_SP2>(lds, g, S, E); }
    }
    GRID_SYNC();
    { PH_BEGIN
    if (ON(14)) { Gemm g{(const bf16_t*)(ws + WS_OA), Wa, T, D, 2048}; StaticOrder S; S.init(T, D, G, (int)blockIdx.x);
      EpiMul<false> E{(const bf16_t*)(ws + WS_SGA), (bf16_t*)(ws + WS_SGA)};
      pg8::gemm_phase<EpiMul<false>, StaticOrder, GEMM_ALIGN, GEMM_SP2>(lds, g, S, E); }
    }
    { PH_BEGIN
    if (ON(15)) { Gemm g{(const bf16_t*)(ws + WS_OB), Wb, T, D, 1024}; StaticOrder S; S.init(T, D, G, (int)blockIdx.x);
      EpiMul<true> E{(const bf16_t*)(ws + WS_SGB), (bf16_t*)(ws + WS_SGA)};
      pg8::gemm_phase<EpiMul<true>, StaticOrder, GEMM_ALIGN, GEMM_SP2>(lds, g, S, E); }
    }
    GRID_SYNC();
    { PH_BEGIN
    if (ON(16)) { Gemm g{(const bf16_t*)(ws + WS_SGA), Wo, T, D, D}; StaticOrder S; S.init(T, D, G, (int)blockIdx.x); EpiRes E{a->out, a->out, mods + 5 * D, 1.0f};
      pg8::gemm_phase<EpiRes, StaticOrder, GEMM_ALIGN, GEMM_SP2>(lds, g, S, E); }
    }
    GRID_SYNC();
    { PH_BEGIN
    if (ON(17)) ln_rows(a->out, a->ln2_g, a->ln2_b, mods, 6, H, gw, NGW, lane);
    }
    GRID_SYNC();
    { PH_BEGIN
    if (ON(18)) { Gemm g{H, Wgu, T, 2 * FF, D}; StaticOrder S; S.init(T, 2 * FF, G, (int)blockIdx.x); EpiGU E{ACT};
      pg8::gemm_phase<EpiGU, StaticOrder, GEMM_ALIGN, GEMM_SP2>(lds, g, S, E); }
    }
    GRID_SYNC();
    { PH_BEGIN
    if (ON(19)) { Gemm g{ACT, Wd, T, D, FF}; StaticOrder S; S.init(T, D, G, (int)blockIdx.x); EpiRes E{a->out, a->out, mods + 8 * D, 0.5f};
      pg8::gemm_phase<EpiRes, StaticOrder, GEMM_ALIGN, GEMM_SP2>(lds, g, S, E); }
    }
    GRID_SYNC();
    { PH_BEGIN
    if (ON(20)) ln_rows(a->out, a->ln3_g, a->ln3_b, mods, 0, nullptr, gw, NGW, lane);
    }
}

extern "C" void kernel_launch(void* const* d_in, const int* in_sizes, int n_in, void* d_out, int out_size, void* d_ws, size_t ws_size, hipStream_t stream) {
    static int grid = 0;
    if (grid == 0) {
        if (n_in != 22 || out_size != T * D || ws_size < WS_END) { fprintf(stderr, "kernel_launch: unexpected shapes: n_in %d out %d ws %zu\n", n_in, out_size, ws_size); grid = -1; return; }
        int dev = 0, cus = 0, per_cu = 0;
        hipGetDevice(&dev); hipDeviceGetAttribute(&cus, hipDeviceAttributeMultiprocessorCount, dev);
        hipFuncSetAttribute((const void*)fwd_megakernel, hipFuncAttributeMaxDynamicSharedMemorySize, LDS_BYTES);
        hipOccupancyMaxActiveBlocksPerMultiprocessor(&per_cu, (const void*)fwd_megakernel, 512, LDS_BYTES);
        (void)hipGetLastError();
        if (per_cu < 1) fprintf(stderr, "kernel_launch: occupancy query says %d blocks/CU\n", per_cu);
        grid = cus;
    }
    if (grid < 0) return;
    Args a{};
    a.x = (const float*)d_in[0]; a.c = (const float*)d_in[1]; a.pos = (const int*)d_in[2]; a.w_ada = (const float*)d_in[3]; a.b_ada = (const float*)d_in[4];
    a.ln1_g = (const float*)d_in[5]; a.ln1_b = (const float*)d_in[6]; a.w_gu1 = (const float*)d_in[7]; a.w_d1 = (const float*)d_in[8];
    a.w_in = (const float*)d_in[9]; a.w_alpha2 = (const float*)d_in[10]; a.b_alpha = (const float*)d_in[11]; a.gla_g = (const float*)d_in[12];
    a.w_a = (const float*)d_in[13]; a.w_b = (const float*)d_in[14]; a.w_o = (const float*)d_in[15]; a.ln2_g = (const float*)d_in[16]; a.ln2_b = (const float*)d_in[17];
    a.w_gu2 = (const float*)d_in[18]; a.w_d2 = (const float*)d_in[19]; a.ln3_g = (const float*)d_in[20]; a.ln3_b = (const float*)d_in[21];
    a.out = (float*)d_out; a.ws = (unsigned char*)d_ws;
    void* args[] = {&a};
    hipError_t e = hipLaunchCooperativeKernel((const void*)fwd_megakernel, dim3(grid), dim3(512), args, LDS_BYTES, stream);
    if (e != hipSuccess) fprintf(stderr, "kernel_launch: cooperative launch failed: %s (grid %d)\n", hipGetErrorString(e), grid);
}
```

```cpp
#include <hip/hip_runtime.h>
#include <hip/hip_cooperative_groups.h>
#include <cstdio>
#include <cstdint>
namespace cg = cooperative_groups;

#define LAS __attribute__((address_space(3)))
typedef unsigned short bf16_t;
typedef short bf16x8 __attribute__((ext_vector_type(8)));
typedef short s16x4 __attribute__((ext_vector_type(4)));
typedef float f32x4 __attribute__((ext_vector_type(4)));
typedef float f32x2 __attribute__((ext_vector_type(2)));
typedef unsigned u32x4 __attribute__((ext_vector_type(4)));
typedef unsigned u32x2 __attribute__((ext_vector_type(2)));

__device__ __forceinline__ int tid_local() { int t = threadIdx.x; asm volatile("" : "+v"(t)); return t; }

namespace pg8 {
constexpr int BM = 256, BK = 64, HALF = 128, HTB = HALF * BK * 2, STAGE_BYTES = 8 * HTB, NXCD = 8, WGM = 8;
__host__ __device__ __forceinline__ int lds_byte(int r, int c) { const int st = (r >> 4) * 2 + (c >> 5), rr = r & 15, cc = c & 31, ob = rr * 64 + cc * 2; return st * 1024 + (ob ^ (((ob >> 9) & 1) << 5)); }
__host__ __device__ __forceinline__ void stage_rc(int b, int& R, int& C) { const int st = b / 1024, sb = b % 1024, swz = sb ^ (((sb >> 9) & 1) << 5); R = (st >> 1) * 16 + swz / 64; C = (st & 1) * 32 + (swz % 64) / 2; }
__host__ __device__ __forceinline__ int perm32(int rho) { const int n = rho >> 4, i = rho & 15; return 8 * (i >> 2) + 4 * n + (i & 3); }
struct Unit { int pm, pn; };
struct Gemm { const bf16_t* A; const bf16_t* Bt; int M, N, K; };
struct StaticOrder {
    int nM, nN, nwg, G, c;
    __device__ void init(int M, int N, int G_, int c_) { nM = M / BM; nN = N / BM; nwg = nM * nN; G = G_; c = c_; }
    __device__ bool next(int i, Unit& u) const {
        const long L = (long)i * G + c; if (L >= nwg) return false;
        int wgid = (int)L; { const int q = nwg / NXCD, r = nwg % NXCD, xcd = wgid % NXCD, off = wgid / NXCD; wgid = (xcd < r ? xcd * (q + 1) : r * (q + 1) + (xcd - r) * q) + off; }
        const int nig = WGM * nN, gid = wgid / nig, fm = gid * WGM, gsz = (nM - fm) < WGM ? (nM - fm) : WGM;
        u.pm = fm + ((wgid % nig) % gsz); u.pn = (wgid % nig) / gsz; return true;
    }
    __device__ __forceinline__ void a_ready(const Unit&) const {}
    __device__ __forceinline__ void done(const Unit&) const {}
};
typedef float f32x2_t __attribute__((ext_vector_type(2)));
typedef __bf16 bf16x2_t __attribute__((ext_vector_type(2)));
__device__ __forceinline__ unsigned cvt_pk_bf16(float lo, float hi) { f32x2_t v = {lo, hi}; bf16x2_t b = __builtin_convertvector(v, bf16x2_t); return __builtin_bit_cast(unsigned, b); }

template <class Epi, class Sched, bool ALIGN_EPI = false, bool SP2 = false>
__device__ __forceinline__ void gemm_phase(LAS unsigned char* lds, const Gemm g, const Sched& S, const Epi& E) {
    const int tid = tid_local(), wid = __builtin_amdgcn_readfirstlane(tid >> 6), lane = tid & 63, wr = wid >> 2, wc = wid & 3, fr = lane & 15, fq = lane >> 4;
    const int K = g.K, nt = K / BK;
    unsigned voffA[2], voffB[2];
#pragma unroll
    for (int i = 0; i < 2; ++i) { int R, C; stage_rc(tid * 16 + i * 8192, R, C); const int Rb = Epi::PERM ? ((R & ~31) + perm32(R & 31)) : R;
        voffA[i] = (unsigned)(R * K + C) * 2u; voffB[i] = (unsigned)(Rb * K + C) * 2u; }
    const size_t kstep = (size_t)(BK * 2);
    const size_t hstep = (size_t)HALF * K * 2;
    const size_t tstep = 2 * hstep;
    const unsigned ldsw = (unsigned)wid * 1024u;
    const int aoff = lds_byte(wr * 64 + fr, fq * 8), boff = lds_byte(wc * 32 + fr, fq * 8);
#define PG8_SA(b, h) (((b) * 2 + (h)) * HTB)
#define PG8_SB(b, h) ((4 + (b) * 2 + (h)) * HTB)
#define PG8_STAGE(bufoff, gbase, voff) do { _Pragma("unroll") for (int _i = 0; _i < 2; ++_i) \
        __builtin_amdgcn_global_load_lds((const unsigned*)((const char*)(gbase) + (voff)[_i]), (LAS unsigned*)(lds + (bufoff) + ldsw + _i * 8192), 16, 0, 1); } while (0)
#define PG8_LDA(dst, b, h) do { _Pragma("unroll") for (int m = 0; m < 4; ++m) _Pragma("unroll") for (int k = 0; k < 2; ++k) dst[m][k] = *(const LAS bf16x8*)(lds + PG8_SA(b, h) + aoff + m * 2048 + k * 1024); } while (0)
#define PG8_LDB(dst, b, h) do { _Pragma("unroll") for (int n = 0; n < 2; ++n) _Pragma("unroll") for (int k = 0; k < 2; ++k) dst[n][k] = *(const LAS bf16x8*)(lds + PG8_SB(b, h) + boff + n * 2048 + k * 1024); } while (0)
#define PG8_MMA(ai, bj, At, Bt) do { __builtin_amdgcn_s_setprio(1); _Pragma("unroll") for (int m = 0; m < 4; ++m) _Pragma("unroll") for (int n = 0; n < 2; ++n) _Pragma("unroll") for (int k = 0; k < 2; ++k) \
        acc[ai][bj][m][n] = __builtin_amdgcn_mfma_f32_16x16x32_bf16(Bt[n][k], At[m][k], acc[ai][bj][m][n], 0, 0, 0); __builtin_amdgcn_s_setprio(0); } while (0)
#define PG8_WAIT_V(n) asm volatile("s_waitcnt vmcnt(" #n ")" ::: "memory")
#define PG8_WAIT_L(n) asm volatile("s_waitcnt lgkmcnt(" #n ")" ::: "memory")
#define PG8_BAR __builtin_amdgcn_s_barrier()
#define PG8_SCHED __builtin_amdgcn_sched_barrier(0)
    Unit cur, nxt; int ui = 0;
    if (!S.next(0, cur)) return;
    f32x4 acc[2][2][4][2];
#pragma unroll
    for (int a = 0; a < 2; ++a)
#pragma unroll
        for (int b = 0; b < 2; ++b)
#pragma unroll
            for (int m = 0; m < 4; ++m)
#pragma unroll
                for (int n = 0; n < 2; ++n) acc[a][b][m][n] = (f32x4){0.f, 0.f, 0.f, 0.f};
    bf16x8 At[4][2], B0[2][2], B1[2][2];
    const char* cA = (const char*)g.A + (size_t)cur.pm * tstep; const char* cB = (const char*)g.Bt + (size_t)cur.pn * tstep;
    S.a_ready(cur);
    if constexpr (SP2) {
        PG8_STAGE(PG8_SB(0, 0), cB, voffB); PG8_STAGE(PG8_SB(0, 1), cB + hstep, voffB); PG8_STAGE(PG8_SA(0, 0), cA, voffA); PG8_STAGE(PG8_SA(0, 1), cA + hstep, voffA);
        if (wr == 1) PG8_BAR;
        PG8_WAIT_V(2); PG8_BAR;
        PG8_STAGE(PG8_SB(1, 0), cB + kstep, voffB); PG8_STAGE(PG8_SA(1, 0), cA + kstep, voffA); PG8_STAGE(PG8_SB(1, 1), cB + hstep + kstep, voffB);
        PG8_WAIT_V(6); PG8_BAR;
    } else {
        PG8_STAGE(PG8_SB(0, 0), cB, voffB); PG8_STAGE(PG8_SA(0, 0), cA, voffA); PG8_STAGE(PG8_SB(0, 1), cB + hstep, voffB); PG8_STAGE(PG8_SA(0, 1), cA + hstep, voffA);
        if (wr == 1) PG8_BAR;
        PG8_WAIT_V(4); PG8_BAR;
        PG8_STAGE(PG8_SB(1, 0), cB + kstep, voffB); PG8_STAGE(PG8_SA(1, 0), cA + kstep, voffA); PG8_STAGE(PG8_SB(1, 1), cB + hstep + kstep, voffB);
        PG8_WAIT_V(6); PG8_BAR;
    }
    for (;;) {
        const bool has_next = S.next(ui + 1, nxt);
        const char* nA = has_next ? (const char*)g.A + (size_t)nxt.pm * tstep : cA; const char* nB = has_next ? (const char*)g.Bt + (size_t)nxt.pn * tstep : cB;
        for (int t = 0; t < nt; t += 2) {
            const bool last = (t == nt - 2);
            const char* a1 = cA + (size_t)(t + 1) * kstep;
            const char* a2 = last ? nA : cA + (size_t)(t + 2) * kstep; const char* b2 = last ? nB : cB + (size_t)(t + 2) * kstep;
            const char* a3 = a2 + kstep; const char* b3 = b2 + kstep;
            if (last && has_next) S.a_ready(nxt);
            if constexpr (SP2) {
            PG8_LDB(B0, 0, 0); PG8_LDB(B1, 0, 1); PG8_SCHED; PG8_LDA(At, 0, 0); PG8_STAGE(PG8_SA(1, 1), a1 + hstep, voffA);
            PG8_WAIT_V(8); PG8_WAIT_L(0); PG8_BAR; PG8_MMA(0, 0, At, B0); PG8_MMA(0, 1, At, B1); PG8_BAR; PG8_SCHED;
            PG8_LDA(At, 0, 1); PG8_STAGE(PG8_SB(0, 0), b2, voffB); PG8_STAGE(PG8_SB(0, 1), b2 + hstep, voffB); PG8_STAGE(PG8_SA(0, 0), a2, voffA);
            PG8_WAIT_V(8); PG8_WAIT_L(0); PG8_BAR; PG8_MMA(1, 0, At, B0); PG8_MMA(1, 1, At, B1); PG8_BAR; PG8_SCHED;
            PG8_LDB(B0, 1, 0); PG8_LDB(B1, 1, 1); PG8_SCHED; PG8_LDA(At, 1, 0); PG8_STAGE(PG8_SA(0, 1), a2 + hstep, voffA);
            PG8_WAIT_V(8); PG8_WAIT_L(0); PG8_BAR; PG8_MMA(0, 0, At, B0); PG8_MMA(0, 1, At, B1); PG8_BAR; PG8_SCHED;
            PG8_LDA(At, 1, 1); PG8_STAGE(PG8_SB(1, 0), b3, voffB); PG8_STAGE(PG8_SB(1, 1), b3 + hstep, voffB); PG8_STAGE(PG8_SA(1, 0), a3, voffA);
            PG8_WAIT_V(8); PG8_WAIT_L(0); PG8_BAR; PG8_MMA(1, 0, At, B0); PG8_MMA(1, 1, At, B1); PG8_BAR; PG8_SCHED;
            } else {
            PG8_LDB(B0, 0, 0); PG8_SCHED; PG8_LDA(At, 0, 0); PG8_STAGE(PG8_SA(1, 1), a1 + hstep, voffA);
            PG8_WAIT_L(8); PG8_BAR; PG8_WAIT_L(0); PG8_MMA(0, 0, At, B0); PG8_BAR; PG8_SCHED;
            PG8_LDB(B1, 0, 1); PG8_STAGE(PG8_SB(0, 0), b2, voffB);
            PG8_BAR; PG8_WAIT_L(0); PG8_MMA(0, 1, At, B1); PG8_BAR;
            PG8_LDA(At, 0, 1); PG8_STAGE(PG8_SA(0, 0), a2, voffA);
            PG8_BAR; PG8_WAIT_L(0); PG8_MMA(1, 0, At, B0); PG8_BAR; PG8_SCHED;
            PG8_STAGE(PG8_SB(0, 1), b2 + hstep, voffB);
            PG8_WAIT_V(6); PG8_BAR; PG8_MMA(1, 1, At, B1); PG8_BAR;
            PG8_LDB(B0, 1, 0); PG8_SCHED; PG8_LDA(At, 1, 0); PG8_STAGE(PG8_SA(0, 1), a2 + hstep, voffA);
            PG8_WAIT_L(8); PG8_BAR; PG8_WAIT_L(0); PG8_MMA(0, 0, At, B0); PG8_BAR; PG8_SCHED;
            PG8_LDB(B1, 1, 1); PG8_STAGE(PG8_SB(1, 0), b3, voffB);
            PG8_BAR; PG8_WAIT_L(0); PG8_MMA(0, 1, At, B1); PG8_BAR;
            PG8_LDA(At, 1, 1); PG8_STAGE(PG8_SA(1, 0), a3, voffA);
            PG8_BAR; PG8_WAIT_L(0); PG8_MMA(1, 0, At, B0); PG8_BAR; PG8_SCHED;
            PG8_STAGE(PG8_SB(1, 1), b3 + hstep, voffB);
            PG8_WAIT_V(6); PG8_BAR; PG8_MMA(1, 1, At, B1); PG8_BAR;
            }
        }
        if constexpr (ALIGN_EPI) { if (wr == 0) PG8_BAR; }
        E(acc, cur, wr, wc, fr, fq);
        if (!has_next) break;
#pragma unroll
        for (int a = 0; a < 2; ++a)
#pragma unroll
            for (int b = 0; b < 2; ++b)
#pragma unroll
                for (int m = 0; m < 4; ++m)
#pragma unroll
                    for (int n = 0; n < 2; ++n) acc[a][b][m][n] = (f32x4){0.f, 0.f, 0.f, 0.f};
        cur = nxt; cA = nA; cB = nB; ++ui;
        if constexpr (ALIGN_EPI) { if (wr == 1) PG8_BAR; }
    }
    PG8_WAIT_V(0);
    if constexpr (!ALIGN_EPI) { if (wr == 0) PG8_BAR; }
    PG8_BAR;
#undef PG8_SA
#undef PG8_SB
#undef PG8_STAGE
#undef PG8_LDA
#undef PG8_LDB
#undef PG8_MMA
#undef PG8_WAIT_V
#undef PG8_WAIT_L
#undef PG8_BAR
#undef PG8_SCHED
}
}

constexpr int NB = 4, SEQ = 8192, T = NB * SEQ, D = 2048, FF = 5632, NMOD = 9;
constexpr int TH = T / 2;
constexpr float LN_EPS = 1e-5f;
constexpr float DN_ALPHA = 1.189207115002721f;
constexpr int WIN_SRC = 19472;
constexpr int WIN_ROWS = 77 * 256;
constexpr int WR_GLA = 0, WR_GLR = 6144, WR_DQ = 6400, WR_DK = 9472, WR_DV = 12544, WR_GATE = 15616;

constexpr size_t MiB = 1u << 20;
constexpr size_t WS_MODS = 0;
constexpr size_t CTL_ZERO_BYTES = 1 * MiB;
constexpr size_t WS_GLR = 1 * MiB;
constexpr size_t WS_AIN = 3 * MiB;
constexpr size_t WS_COS = 3 * MiB, WS_SIN = 11 * MiB;
constexpr size_t WS_DEC = 19 * MiB;
constexpr size_t WS_LSE = 21 * MiB;
constexpr size_t WS_WGU = 23 * MiB;
constexpr size_t WS_WD = 67 * MiB;
constexpr size_t WS_WIN = 89 * MiB;
constexpr size_t WS_WA = 166 * MiB, WS_WB = 174 * MiB, WS_WO = 178 * MiB;
constexpr size_t WS_H = 186 * MiB;
constexpr size_t WS_ACT = 314 * MiB;
constexpr size_t WS_Q = 314 * MiB, WS_K = 378 * MiB, WS_V = 442 * MiB, WS_R = 570 * MiB, WS_ORAW = 698 * MiB;
constexpr size_t WS_OA = 314 * MiB;
constexpr size_t WS_DQ = 442 * MiB, WS_DK = 538 * MiB, WS_DV = 634 * MiB;
constexpr size_t WS_OB = 730 * MiB;
constexpr size_t WS_OG = 794 * MiB;
constexpr size_t WS_SGA = 442 * MiB, WS_SGB = 570 * MiB;
constexpr size_t WS_END = 954 * MiB;

constexpr int LDS_BYTES = 147456;

struct Args {
    const float* x; const float* c; const int* pos; const float* w_ada; const float* b_ada;
    const float* ln1_g; const float* ln1_b; const float* w_gu1; const float* w_d1;
    const float* w_in; const float* w_alpha2; const float* b_alpha; const float* gla_g;
    const float* w_a; const float* w_b; const float* w_o; const float* ln2_g; const float* ln2_b;
    const float* w_gu2; const float* w_d2; const float* ln3_g; const float* ln3_b;
    float* out; unsigned char* ws;
};

typedef const Args __attribute__((address_space(4)))* CArgs;
__device__ __forceinline__ CArgs launder(CArgs p) { asm volatile("" : "+s"(p)); return p; }

__device__ __forceinline__ unsigned pk2(float lo, float hi) { return pg8::cvt_pk_bf16(lo, hi); }
__device__ __forceinline__ float bf_lo(unsigned w) { return __uint_as_float(w << 16); }
__device__ __forceinline__ float bf_hi(unsigned w) { return __uint_as_float(w & 0xffff0000u); }
__device__ __forceinline__ float bf2f(bf16_t h) { return __uint_as_float(((unsigned)h) << 16); }
__device__ __forceinline__ bf16_t f2bf(float f) { unsigned u = __float_as_uint(f); return (bf16_t)((u + 0x7fffu + ((u >> 16) & 1u)) >> 16); }
__device__ __forceinline__ float fast_rcp(float x) { return __builtin_amdgcn_rcpf(x); }
__device__ __forceinline__ float sigmoidf_(float x) { return fast_rcp(1.0f + __expf(-x)); }
__device__ __forceinline__ float siluf_(float x) { return x * sigmoidf_(x); }
__device__ __forceinline__ float wave_sum(float v) {
#pragma unroll
    for (int o = 1; o < 64; o <<= 1) v += __shfl_xor(v, o);
    return v;
}
__device__ __forceinline__ s16x4 tr4(const LAS unsigned char* p) { return __builtin_bit_cast(s16x4, __builtin_amdgcn_ds_read_tr16_b64_v4i16((LAS s16x4*)p)); }
__device__ __forceinline__ bf16x8 cat8(s16x4 a, s16x4 b) { return (bf16x8){a[0], a[1], a[2], a[3], b[0], b[1], b[2], b[3]}; }
#define MFMA16(a, b, c) __builtin_amdgcn_mfma_f32_16x16x32_bf16((a), (b), (c), 0, 0, 0)

struct EpiGU {
    static constexpr bool PERM = true;
    bf16_t* O;
    __device__ __forceinline__ void operator()(const f32x4 (&acc)[2][2][4][2], const pg8::Unit& u, int wr, int wc, int fr, int fq) const {
        const int row0 = u.pm * 256 + wr * 64 + fr, col0 = u.pn * 128 + wc * 32 + 8 * fq;
#pragma unroll
        for (int ai = 0; ai < 2; ++ai)
#pragma unroll
            for (int m = 0; m < 4; ++m) {
                const f32x4 g0 = acc[ai][0][m][0], g1 = acc[ai][0][m][1], u0 = acc[ai][1][m][0], u1 = acc[ai][1][m][1];
                u32x4 w;
                w.x = pk2(siluf_(g0[0]) * u0[0], siluf_(g0[1]) * u0[1]); w.y = pk2(siluf_(g0[2]) * u0[2], siluf_(g0[3]) * u0[3]);
                w.z = pk2(siluf_(g1[0]) * u1[0], siluf_(g1[1]) * u1[1]); w.w = pk2(siluf_(g1[2]) * u1[2], siluf_(g1[3]) * u1[3]);
                *(u32x4*)(O + (size_t)(row0 + ai * 128 + m * 16) * FF + col0) = w;
            }
    }
};
struct EpiRes {
    static constexpr bool PERM = false;
    const float* res; float* out; const float* gate; float gs;
    __device__ __forceinline__ void operator()(const f32x4 (&acc)[2][2][4][2], const pg8::Unit& u, int wr, int wc, int fr, int fq) const {
        const int row0 = u.pm * 256 + wr * 64 + fr, col0 = u.pn * 256 + wc * 32 + 4 * fq;
        const float* gp = gate + (size_t)(u.pm >> 5) * (NMOD * D) + col0;
        f32x4 gv[2][2];
#pragma unroll
        for (int bj = 0; bj < 2; ++bj)
#pragma unroll
            for (int n = 0; n < 2; ++n) gv[bj][n] = *(const f32x4*)(gp + bj * 128 + n * 16) * gs;
#pragma unroll
        for (int ai = 0; ai < 2; ++ai)
#pragma unroll
            for (int m = 0; m < 4; ++m) {
                const size_t off = (size_t)(row0 + ai * 128 + m * 16) * D + col0;
#pragma unroll
                for (int bj = 0; bj < 2; ++bj)
#pragma unroll
                    for (int n = 0; n < 2; ++n) {
                        const f32x4 r = *(const f32x4*)(res + off + bj * 128 + n * 16);
                        *(f32x4*)(out + off + bj * 128 + n * 16) = r * DN_ALPHA + gv[bj][n] * acc[ai][bj][m][n];
                    }
                if (m & 1) asm volatile("" ::: "memory");
            }
    }
};
__device__ __forceinline__ void store8(bf16_t* p, const f32x4& a, const f32x4& b) {
    u32x4 w; w.x = pk2(a[0], a[1]); w.y = pk2(a[2], a[3]); w.z = pk2(b[0], b[1]); w.w = pk2(b[2], b[3]);
    *(u32x4*)p = w;
}
struct EpiGla {
    static constexpr bool PERM = true;
    bf16_t *Q, *Kk, *V, *R; float* GLR;
    __device__ __forceinline__ void operator()(const f32x4 (&acc)[2][2][4][2], const pg8::Unit& u, int wr, int wc, int fr, int fq) const {
        const int row0 = u.pm * 256 + wr * 64 + fr;
        if (u.pn < 24) {
            bf16_t* base; int ldc, colt;
            if (u.pn < 4) { base = Q; ldc = 1024; colt = u.pn * 256; }
            else if (u.pn < 8) { base = Kk; ldc = 1024; colt = (u.pn - 4) * 256; }
            else if (u.pn < 16) { base = V; ldc = 2048; colt = (u.pn - 8) * 256; }
            else { base = R; ldc = 2048; colt = (u.pn - 16) * 256; }
            const int col0 = colt + wc * 32 + 8 * fq;
#pragma unroll
            for (int ai = 0; ai < 2; ++ai)
#pragma unroll
                for (int m = 0; m < 4; ++m) {
                    bf16_t* rowp = base + (size_t)(row0 + ai * 128 + m * 16) * ldc + col0;
#pragma unroll
                    for (int bj = 0; bj < 2; ++bj) store8(rowp + bj * 128, acc[ai][bj][m][0], acc[ai][bj][m][1]);
                }
        } else if (wc == 0 && fq < 2) {
#pragma unroll
            for (int ai = 0; ai < 2; ++ai)
#pragma unroll
                for (int m = 0; m < 4; ++m) {
                    float* rowp = GLR + (size_t)(row0 + ai * 128 + m * 16) * 16 + 8 * fq;
                    *(f32x4*)rowp = acc[ai][0][m][0]; *(f32x4*)(rowp + 4) = acc[ai][0][m][1];
                }
        }
    }
};
struct EpiDil {
    static constexpr bool PERM = true;
    bf16_t *DQ, *DK, *DV; const float* cosT; const float* sinT;
    __device__ __forceinline__ void operator()(const f32x4 (&acc)[2][2][4][2], const pg8::Unit& u, int wr, int wc, int fr, int fq) const {
        const int row0 = u.pm * 256 + wr * 64 + fr;
        const int seg = u.pn / 12, colt = (u.pn - seg * 12) * 256;
        bf16_t* base = DQ + (size_t)seg * ((size_t)TH * 3072);
        const int col0 = colt + wc * 32 + 8 * fq;
        if (seg == 2) {
#pragma unroll
            for (int ai = 0; ai < 2; ++ai)
#pragma unroll
                for (int m = 0; m < 4; ++m) {
                    bf16_t* rowp = base + (size_t)(row0 + ai * 128 + m * 16) * 3072 + col0;
#pragma unroll
                    for (int bj = 0; bj < 2; ++bj) store8(rowp + bj * 128, acc[ai][bj][m][0], acc[ai][bj][m][1]);
                }
        } else {
            const float sc = seg == 0 ? 0.08838834764831845f : 1.0f;
            const int g4 = 4 * (4 * wc + fq);
#pragma unroll
            for (int ai = 0; ai < 2; ++ai)
#pragma unroll
                for (int m = 0; m < 4; ++m) {
                    const int row = row0 + ai * 128 + m * 16;
                    const f32x4 c4 = *(const f32x4*)(cosT + (size_t)row * 64 + g4) * sc, s4 = *(const f32x4*)(sinT + (size_t)row * 64 + g4) * sc;
                    bf16_t* rowp = base + (size_t)row * 3072 + col0;
#pragma unroll
                    for (int bj = 0; bj < 2; ++bj) {
                        const f32x4 x1 = acc[ai][bj][m][0], x2 = acc[ai][bj][m][1];
                        store8(rowp + bj * 128, x1 * c4 - x2 * s4, x2 * c4 + x1 * s4);
                    }
                    asm volatile("" ::: "memory");
                }
        }
    }
};
struct EpiGates {
    static constexpr bool PERM = true;
    bf16_t *SGA, *SGB;
    __device__ __forceinline__ void operator()(const f32x4 (&acc)[2][2][4][2], const pg8::Unit& u, int wr, int wc, int fr, int fq) const {
        const int row0 = u.pm * 256 + wr * 64 + fr;
        bf16_t* base = u.pn < 8 ? SGA : SGB;
        const int col0 = (u.pn & 7) * 256 + wc * 32 + 8 * fq;
#pragma unroll
        for (int ai = 0; ai < 2; ++ai)
#pragma unroll
            for (int m = 0; m < 4; ++m) {
                bf16_t* rowp = base + (size_t)(row0 + ai * 128 + m * 16) * D + col0;
#pragma unroll
                for (int bj = 0; bj < 2; ++bj) {
                    f32x4 a = acc[ai][bj][m][0], b = acc[ai][bj][m][1];
#pragma unroll
                    for (int j = 0; j < 4; ++j) { a[j] = sigmoidf_(a[j]); b[j] = sigmoidf_(b[j]); }
                    store8(rowp + bj * 128, a, b);
                }
            }
    }
};
template <bool ADD> struct EpiMul {
    static constexpr bool PERM = true;
    const bf16_t* gate; bf16_t* io;
    __device__ __forceinline__ void operator()(const f32x4 (&acc)[2][2][4][2], const pg8::Unit& u, int wr, int wc, int fr, int fq) const {
        const int row0 = u.pm * 256 + wr * 64 + fr, col0 = u.pn * 256 + wc * 32 + 8 * fq;
#pragma unroll
        for (int ai = 0; ai < 2; ++ai)
#pragma unroll
            for (int m = 0; m < 4; ++m) {
                const size_t off = (size_t)(row0 + ai * 128 + m * 16) * D + col0;
#pragma unroll
                for (int bj = 0; bj < 2; ++bj) {
                    const u32x4 gw = *(const u32x4*)(gate + off + bj * 128);
                    f32x4 a = acc[ai][bj][m][0], b = acc[ai][bj][m][1];
                    a[0] *= bf_lo(gw.x); a[1] *= bf_hi(gw.x); a[2] *= bf_lo(gw.y); a[3] *= bf_hi(gw.y);
                    b[0] *= bf_lo(gw.z); b[1] *= bf_hi(gw.z); b[2] *= bf_lo(gw.w); b[3] *= bf_hi(gw.w);
                    if (ADD) {
                        const u32x4 tw = *(const u32x4*)(io + off + bj * 128);
                        a[0] += bf_lo(tw.x); a[1] += bf_hi(tw.x); a[2] += bf_lo(tw.y); a[3] += bf_hi(tw.y);
                        b[0] += bf_lo(tw.z); b[1] += bf_hi(tw.z); b[2] += bf_lo(tw.w); b[3] += bf_hi(tw.w);
                    }
                    store8(io + off + bj * 128, a, b);
                }
            }
    }
};

__device__ __forceinline__ void mods_item(CArgs a, float* mods, LAS float* scr, int item, int lane) {
    const int cg_ = item % 72, kc = item / 72, k0 = kc * 128, col = cg_ * 256 + 4 * lane;
#pragma unroll
    for (int i = 0; i < 8; ++i) { const int e = lane + 64 * i, b = e >> 7, kk = e & 127; scr[e] = siluf_(a->c[b * D + k0 + kk]); }
    asm volatile("s_waitcnt lgkmcnt(0)" ::: "memory");
    f32x4 s0 = {0, 0, 0, 0}, s1 = s0, s2 = s0, s3 = s0;
    const float* wp = a->w_ada + (size_t)k0 * (NMOD * D) + col;
#pragma unroll 8
    for (int kk = 0; kk < 128; ++kk) {
        const f32x4 w = *(const f32x4*)(wp + (size_t)kk * (NMOD * D));
        s0 += w * scr[kk]; s1 += w * scr[128 + kk]; s2 += w * scr[256 + kk]; s3 += w * scr[384 + kk];
    }
    if (kc == 0) { const f32x4 bb = *(const f32x4*)(a->b_ada + col); s0 += bb; s1 += bb; s2 += bb; s3 += bb; }
#pragma unroll
    for (int j = 0; j < 4; ++j) {
        atomicAdd(mods + 0 * NMOD * D + col + j, s0[j]); atomicAdd(mods + 1 * NMOD * D + col + j, s1[j]);
        atomicAdd(mods + 2 * NMOD * D + col + j, s2[j]); atomicAdd(mods + 3 * NMOD * D + col + j, s3[j]);
    }
    asm volatile("s_waitcnt lgkmcnt(0)" ::: "memory");
}
__device__ __forceinline__ int srccol(int mode, int n, int src0) {
    if (mode == 0) return src0 + n;
    if (mode == 1) { const int head = n >> 7, p = n & 127, g = p >> 3, nn = (p >> 2) & 1, j = p & 3; return src0 + head * 128 + 4 * g + j + 64 * nn; }
    const int pn = n >> 8, rr = n & 255; return rr < 128 ? pn * 128 + rr : FF + pn * 128 + rr - 128;
}
__device__ __forceinline__ void transpose_item(const float* W, int K, int N, bf16_t* WT, int dst0, int src0, int mode, int nblk, LAS float* scr, int item, int lane) {
    const int kb = item / nblk, nb = item % nblk, k0 = 64 * kb, n0 = 32 * nb;
    const int sc = srccol(mode, n0 + (lane & 31), src0);
#pragma unroll 8
    for (int i = 0; i < 32; ++i) { const int kk = 2 * i + (lane >> 5); scr[kk * 33 + (lane & 31)] = W[(size_t)(k0 + kk) * N + sc]; }
    asm volatile("s_waitcnt lgkmcnt(0)" ::: "memory");
    const int c = lane & 7;
#pragma unroll
    for (int j = 0; j < 4; ++j) { const int n = (lane >> 3) + 8 * j; const LAS float* s = scr + (8 * c) * 33 + n;
        u32x4 o; o.x = pk2(s[0 * 33], s[1 * 33]); o.y = pk2(s[2 * 33], s[3 * 33]); o.z = pk2(s[4 * 33], s[5 * 33]); o.w = pk2(s[6 * 33], s[7 * 33]);
        *(u32x4*)(WT + (size_t)(dst0 + n0 + n) * K + k0 + 8 * c) = o; }
    asm volatile("s_waitcnt lgkmcnt(0)" ::: "memory");
}
__device__ __forceinline__ bool tj(const float* W, int K, int N, bf16_t* WT, int dst0, int nrows, int src0, int mode, int& r, LAS float* scr, int lane) {
    const int cnt = (K / 64) * (nrows / 32);
    if (r < cnt) { transpose_item(W, K, N, WT, dst0, src0, mode, nrows / 32, scr, r, lane); return true; }
    r -= cnt; return false;
}

__device__ __forceinline__ void modulate_rows(const float* x, const float* mods, int ch_shift, bf16_t* h, int gw, int NGW, int lane) {
    for (int m = gw; m < T; m += NGW) {
        const float* mp = mods + (size_t)(m / SEQ) * (NMOD * D) + ch_shift * D;
        const f32x4* xr = (const f32x4*)(x + (size_t)m * D) + lane;
        u32x2* o8 = (u32x2*)(h + (size_t)m * D) + lane;
#pragma unroll
        for (int j = 0; j < 8; ++j) {
            const f32x4 v = xr[64 * j], sh = ((const f32x4*)mp)[lane + 64 * j], sc = ((const f32x4*)(mp + D))[lane + 64 * j];
            const f32x4 r = v * (sc + 1.0f) + sh;
            u32x2 w; w.x = pk2(r[0], r[1]); w.y = pk2(r[2], r[3]); o8[64 * j] = w;
        }
    }
}
__device__ __forceinline__ void ln_rows(float* y, const float* g, const float* bta, const float* mods, int ch_shift, bf16_t* h, int gw, int NGW, int lane) {
    for (int m = gw; m < T; m += NGW) {
        f32x4* yr = (f32x4*)(y + (size_t)m * D) + lane;
        f32x4 v[8]; float s = 0.f;
#pragma unroll
        for (int j = 0; j < 8; ++j) { v[j] = yr[64 * j]; s += (v[j][0] + v[j][1]) + (v[j][2] + v[j][3]); }
        const float mean = wave_sum(s) * (1.f / D); float s2 = 0.f;
#pragma unroll
        for (int j = 0; j < 8; ++j) { v[j] = v[j] - mean; s2 += (v[j][0] * v[j][0] + v[j][1] * v[j][1]) + (v[j][2] * v[j][2] + v[j][3] * v[j][3]); }
        const float rstd = 1.f / sqrtf(wave_sum(s2) * (1.f / D) + LN_EPS);
#pragma unroll
        for (int j = 0; j < 8; ++j) {
            const f32x4 gg = ((const f32x4*)g)[lane + 64 * j], bb = ((const f32x4*)bta)[lane + 64 * j];
            v[j] = v[j] * rstd * gg + bb; yr[64 * j] = v[j];
        }
        if (h) {
            const float* mp = mods + (size_t)(m / SEQ) * (NMOD * D) + ch_shift * D;
            u32x2* o8 = (u32x2*)(h + (size_t)m * D) + lane;
#pragma unroll
            for (int j = 0; j < 8; ++j) {
                const f32x4 sh = ((const f32x4*)mp)[lane + 64 * j], sc = ((const f32x4*)(mp + D))[lane + 64 * j];
                const f32x4 r = v[j] * (sc + 1.0f) + sh;
                u32x2 w; w.x = pk2(r[0], r[1]); w.y = pk2(r[2], r[3]); o8[64 * j] = w;
            }
        }
    }
}

constexpr int GP = 264;
constexpr int VP = 72;
__device__ __forceinline__ void gla_prep(CArgs a, LAS unsigned char* lds) {
    unsigned char* ws = a->ws;
    bf16_t* Q = (bf16_t*)(ws + WS_Q); bf16_t* Kk = (bf16_t*)(ws + WS_K); const float* GLR = (const float*)(ws + WS_GLR);
    bf16_t* AIN = (bf16_t*)(ws + WS_AIN); float* DEC = (float*)(ws + WS_DEC);
    const int tid = tid_local(), lane = tid & 63, wid = __builtin_amdgcn_readfirstlane(tid >> 6), fr = lane & 15, fq = lane >> 4;
    LAS unsigned char* Qd = lds; LAS unsigned char* Ki = lds + 64 * GP * 2; LAS float* tot = (LAS float*)(lds + 2 * 64 * GP * 2);
    const int dk = tid & 255, half = __builtin_amdgcn_readfirstlane(tid >> 8);
    for (int unit = blockIdx.x; unit < NB * 4 * 128; unit += gridDim.x) {
        const int c = unit & 127, bh = unit >> 7, h = bh & 3, b = bh >> 2;
        const int t0 = b * SEQ + c * 64;
        LAS float* glr_l = (LAS float*)(lds + 2 * 64 * GP * 2 + 2048);
        if (tid < 256) *(LAS f32x4*)(glr_l + tid * 4) = *(const f32x4*)(GLR + (size_t)t0 * 16 + tid * 4);
        float w2[16];
#pragma unroll
        for (int r = 0; r < 16; ++r) w2[r] = a->w_alpha2[r * 1024 + h * 256 + dk];
        const float ba = a->b_alpha[h * 256 + dk];
        float la[32], qv[32], kv[32]; float run = 0.f;
#pragma unroll
        for (int i = 0; i < 32; ++i) {
            const size_t gi = (size_t)(t0 + half * 32 + i) * 1024 + h * 256 + dk;
            qv[i] = bf2f(Q[gi]); kv[i] = bf2f(Kk[gi]);
        }
        __syncthreads();
#pragma unroll
        for (int i = 0; i < 32; ++i) {
            const LAS f32x4* gp = (const LAS f32x4*)(glr_l + (half * 32 + i) * 16);
            const f32x4 g0 = gp[0], g1 = gp[1], g2 = gp[2], g3 = gp[3];
            float z = ba;
#pragma unroll
            for (int j = 0; j < 4; ++j) { z += g0[j] * w2[j]; z += g1[j] * w2[4 + j]; z += g2[j] * w2[8 + j]; z += g3[j] * w2[12 + j]; }
            const float ls = fminf(z, 0.f) - __logf(1.0f + __expf(-fabsf(z)));
            run += ls * (1.0f / 16.0f); la[i] = run;
        }
        tot[half * 256 + dk] = run;
        __syncthreads();
        const float t0s = tot[dk], t1s = tot[256 + dk];
        const float boff = half ? t0s : 0.f, blast = t0s + t1s, eblast = __expf(blast);
        if (half == 0) DEC[(size_t)unit * 256 + dk] = eblast;
        unsigned kew[16]; float kef_prev = 0.f;
#pragma unroll
        for (int i = 0; i < 32; ++i) {
            const int s = half * 32 + i;
            const float eb = __expf(boff + la[i]);
            const float kif = kv[i] * fast_rcp(eb);
            const bf16_t qd = f2bf(qv[i] * eb * 0.0625f), ki = f2bf(kif);
            *(LAS bf16_t*)(Qd + (s * GP + dk) * 2) = qd; *(LAS bf16_t*)(Ki + (s * GP + dk) * 2) = ki;
            const float kef = kif * eblast;
            if (i & 1) kew[i >> 1] = pk2(kef_prev, kef);
            kef_prev = kef;
        }
        {
            const int jj = (dk >> 4) * 2 + half;
#pragma unroll
            for (int v = 0; v < 4; ++v) { const int l = v * 16 + (dk & 15);
                *(u32x4*)(Kk + (size_t)(t0 + 2 * jj + (l >> 5)) * 1024 + h * 256 + (l & 31) * 8) = (u32x4){kew[4 * v], kew[4 * v + 1], kew[4 * v + 2], kew[4 * v + 3]}; }
        }
        __syncthreads();
#pragma unroll
        for (int i = 0; i < 4; ++i) { const int id = tid + 512 * i, j = id >> 6, l = id & 63;
            const u32x4 w = *(const LAS u32x4*)(Qd + ((16 * (j >> 3) + (l & 15)) * GP + 32 * (j & 7) + 8 * (l >> 4)) * 2);
            *(u32x4*)(Q + (size_t)(t0 + 2 * j + (l >> 5)) * 1024 + h * 256 + (l & 31) * 8) = w; }
        const int rt = wid >> 1, ct0 = (wid & 1) * 2;
        f32x4 o[2] = {{0, 0, 0, 0}, {0, 0, 0, 0}};
#pragma unroll
        for (int kk = 0; kk < 8; ++kk) {
            const bf16x8 af = *(const LAS bf16x8*)(Qd + ((16 * rt + fr) * GP + 32 * kk + 8 * fq) * 2);
#pragma unroll
            for (int c2 = 0; c2 < 2; ++c2) {
                const bf16x8 bfr = *(const LAS bf16x8*)(Ki + ((16 * (ct0 + c2) + fr) * GP + 32 * kk + 8 * fq) * 2);
                o[c2] = MFMA16(af, bfr, o[c2]);
            }
        }
#pragma unroll
        for (int c2 = 0; c2 < 2; ++c2)
#pragma unroll
            for (int j = 0; j < 4; ++j) {
                const int s = 16 * rt + 4 * fq + j, sp = 16 * (ct0 + c2) + fr;
                AIN[(size_t)unit * 4096 + (((rt * 2 + (sp >> 5)) * 64 + ((sp & 31) >> 3) * 16 + (s & 15)) << 3) + (sp & 7)] = f2bf(sp <= s ? o[c2][j] : 0.f);
            }
        __syncthreads();
    }
}
__device__ __forceinline__ void gla_seq(CArgs a, LAS unsigned char* lds) {
    const int blk = blockIdx.x; if (blk >= 128) return;
    unsigned char* ws = a->ws;
    const bf16_t* Q = (const bf16_t*)(ws + WS_Q); const bf16_t* Kk = (const bf16_t*)(ws + WS_K); const bf16_t* V = (const bf16_t*)(ws + WS_V);
    const bf16_t* AIN = (const bf16_t*)(ws + WS_AIN); const float* DEC = (const float*)(ws + WS_DEC); float* ORAW = (float*)(ws + WS_ORAW);
    const int bh = (blk & 7) + 8 * (blk >> 6), dvs = (blk >> 3) & 7, b = bh >> 2, h = bh & 3;
    const int tid = tid_local(), lane = tid & 63, wid = __builtin_amdgcn_readfirstlane(tid >> 6), fr = lane & 15, fq = lane >> 4, qq = fr >> 2, pp = lane & 3;
    constexpr int VB = 64 * VP * 2, SBB = 64 * GP * 2;
    LAS unsigned char* Vl = lds; LAS unsigned char* Sb = lds + 2 * VB;
    for (int e = tid; e < SBB / 16; e += 512) *(LAS u32x4*)(Sb + SBB + e * 16) = (u32x4){0, 0, 0, 0};
    f32x4 S[2][4];
#pragma unroll
    for (int r2 = 0; r2 < 2; ++r2)
#pragma unroll
        for (int ct = 0; ct < 4; ++ct) S[r2][ct] = (f32x4){0, 0, 0, 0};
    const int unit0 = bh * 128, vrow = tid >> 3, vch = tid & 7, rt = wid >> 1, ct0 = (wid & 1) * 2;
    const int dk0 = 16 * (2 * wid) + fr, dk1 = dk0 + 16;
    const size_t fragoff = (size_t)(lane >> 5) * 1024 + h * 256 + (lane & 31) * 8;
    const size_t voff = (size_t)vrow * 2048 + h * 512 + dvs * 64 + vch * 8;
    const int doff = 16 * (2 * wid) + 4 * fq;
    bf16x8 nq[8], na[2], nk[2][2]; f32x4 nd[2]; u32x4 nv;
#define GLA_LOAD(c) do { const size_t tb_ = (size_t)(b * SEQ + (c) * 64); const size_t ub_ = (size_t)(unit0 + (c)); \
        _Pragma("unroll") for (int kk = 0; kk < 8; ++kk) nq[kk] = *(const bf16x8*)(Q + (tb_ + 2 * (rt * 8 + kk)) * 1024 + fragoff); \
        _Pragma("unroll") for (int kk = 0; kk < 2; ++kk) { na[kk] = *(const bf16x8*)(AIN + ub_ * 4096 + ((rt * 2 + kk) * 64 + lane) * 8); \
            nk[0][kk] = *(const bf16x8*)(Kk + (tb_ + 2 * ((2 * wid) * 2 + kk)) * 1024 + fragoff); nk[1][kk] = *(const bf16x8*)(Kk + (tb_ + 2 * ((2 * wid + 1) * 2 + kk)) * 1024 + fragoff); } \
        nd[0] = *(const f32x4*)(DEC + ub_ * 256 + doff); nd[1] = *(const f32x4*)(DEC + ub_ * 256 + doff + 16); } while (0)
    nv = *(const u32x4*)(V + (size_t)(b * SEQ) * 2048 + voff);
    GLA_LOAD(0);
    *(LAS u32x4*)(Vl + (vrow * VP + vch * 8) * 2) = nv;
    __syncthreads();
    for (int c = 0; c < 128; ++c) {
        const int pb = c & 1;
        bf16x8 cq[8], ca[2], ck[2][2]; f32x4 cd[2];
#pragma unroll
        for (int kk = 0; kk < 8; ++kk) cq[kk] = nq[kk];
#pragma unroll
        for (int kk = 0; kk < 2; ++kk) { ca[kk] = na[kk]; ck[0][kk] = nk[0][kk]; ck[1][kk] = nk[1][kk]; }
        cd[0] = nd[0]; cd[1] = nd[1];
        if (c + 1 < 128) { nv = *(const u32x4*)(V + (size_t)(b * SEQ + (c + 1) * 64) * 2048 + voff); GLA_LOAD(c + 1); }
        const LAS unsigned char* Vc = Vl + pb * VB; const LAS unsigned char* Sp = Sb + (pb ^ 1) * SBB;
        {
            f32x4 o[2] = {{0, 0, 0, 0}, {0, 0, 0, 0}};
#pragma unroll
            for (int kk = 0; kk < 2; ++kk)
#pragma unroll
                for (int c2 = 0; c2 < 2; ++c2) {
                    const LAS unsigned char* vp = Vc + ((32 * kk + 8 * fq + qq) * VP + 16 * (ct0 + c2) + 4 * pp) * 2;
                    o[c2] = MFMA16(cat8(tr4(vp), tr4(vp + 4 * VP * 2)), ca[kk], o[c2]);
                }
#pragma unroll
            for (int kk = 0; kk < 8; ++kk)
#pragma unroll
                for (int c2 = 0; c2 < 2; ++c2) {
                    const bf16x8 bfr = *(const LAS bf16x8*)(Sp + ((16 * (ct0 + c2) + fr) * GP + 32 * kk + 8 * fq) * 2);
                    o[c2] = MFMA16(bfr, cq[kk], o[c2]);
                }
            const int t0 = b * SEQ + c * 64;
#pragma unroll
            for (int c2 = 0; c2 < 2; ++c2)
                *(f32x4*)(ORAW + (size_t)(t0 + 16 * rt + fr) * 2048 + h * 512 + dvs * 64 + 16 * (ct0 + c2) + 4 * fq) = o[c2];
        }
        {
#pragma unroll
            for (int r2 = 0; r2 < 2; ++r2)
#pragma unroll
                for (int ct = 0; ct < 4; ++ct) S[r2][ct] = S[r2][ct] * cd[r2];
#pragma unroll
            for (int kk = 0; kk < 2; ++kk)
#pragma unroll
                for (int ct = 0; ct < 4; ++ct) {
                    const LAS unsigned char* vp = Vc + ((32 * kk + 8 * fq + qq) * VP + 16 * ct + 4 * pp) * 2;
                    const bf16x8 bfr = cat8(tr4(vp), tr4(vp + 4 * VP * 2));
#pragma unroll
                    for (int r2 = 0; r2 < 2; ++r2) S[r2][ct] = MFMA16(ck[r2][kk], bfr, S[r2][ct]);
                }
        }
        LAS unsigned char* Sn = Sb + pb * SBB;
#pragma unroll
        for (int r2 = 0; r2 < 2; ++r2)
#pragma unroll
            for (int ct = 0; ct < 4; ++ct) {
                u32x2 w; w.x = pk2(S[r2][ct][0], S[r2][ct][1]); w.y = pk2(S[r2][ct][2], S[r2][ct][3]);
                *(LAS u32x2*)(Sn + ((16 * ct + fr) * GP + 16 * (2 * wid + r2) + 4 * fq) * 2) = w;
            }
        if (c + 1 < 128) *(LAS u32x4*)(Vl + (pb ^ 1) * VB + (vrow * VP + vch * 8) * 2) = nv;
        __syncthreads();
    }
#undef GLA_LOAD
}
__device__ __forceinline__ void gla_norm(CArgs a, int gw, int NGW, int lane) {
    unsigned char* ws = a->ws;
    const float* ORAW = (const float*)(ws + WS_ORAW); const bf16_t* R = (const bf16_t*)(ws + WS_R); bf16_t* OA = (bf16_t*)(ws + WS_OA);
    for (int m = gw; m < T; m += NGW) {
        const f32x4* orow = (const f32x4*)(ORAW + (size_t)m * 2048) + lane;
        const u32x2* rrow = (const u32x2*)(R + (size_t)m * 2048) + lane;
        u32x2* out = (u32x2*)(OA + (size_t)m * 2048) + lane;
        f32x4 v[8];
#pragma unroll
        for (int j = 0; j < 8; ++j) v[j] = orow[64 * j];
#pragma unroll
        for (int hh = 0; hh < 4; ++hh) {
            const f32x4 x0 = v[2 * hh], x1 = v[2 * hh + 1];
            float s = (x0[0] * x0[0] + x0[1] * x0[1]) + (x0[2] * x0[2] + x0[3] * x0[3]) + (x1[0] * x1[0] + x1[1] * x1[1]) + (x1[2] * x1[2] + x1[3] * x1[3]);
            const float rs = 1.0f / sqrtf(wave_sum(s) * (1.0f / 512.0f) + LN_EPS);
#pragma unroll
            for (int jj = 0; jj < 2; ++jj) {
                const int j = 2 * hh + jj;
                const f32x4 gg = ((const f32x4*)a->gla_g)[lane + 64 * j];
                const u32x2 rw = rrow[64 * j];
                const float r0 = bf_lo(rw.x), r1 = bf_hi(rw.x), r2 = bf_lo(rw.y), r3 = bf_hi(rw.y);
                const f32x4 x = v[j] * rs * gg;
                u32x2 w; w.x = pk2(x[0] * siluf_(r0), x[1] * siluf_(r1)); w.y = pk2(x[2] * siluf_(r2), x[3] * siluf_(r3));
                out[64 * j] = w;
            }
        }
    }
}
__device__ __forceinline__ void rope_tables(CArgs a) {
    float* cosT = (float*)(a->ws + WS_COS); float* sinT = (float*)(a->ws + WS_SIN);
    const size_t n = (size_t)T * 64;
    for (size_t e = (size_t)blockIdx.x * 512 + threadIdx.x; e < n; e += (size_t)gridDim.x * 512) {
        const int t = (int)(e >> 6), i = (int)(e & 63);
        const float fr = (float)exp2(-(double)i * (13.287712379549449 / 64.0));
        const float pos = (float)a->pos[t];
        const float ang = pos * fr;
        double rev = (double)ang * 0.15915494309189535; rev -= floor(rev);
        const float rv = (float)rev;
        cosT[e] = __builtin_amdgcn_cosf(rv); sinT[e] = __builtin_amdgcn_sinf(rv);
    }
}

constexpr int KP = 136;
__device__ __forceinline__ void dil_attn(CArgs a, LAS unsigned char* lds) {
    unsigned char* ws = a->ws;
    const bf16_t* DQ = (const bf16_t*)(ws + WS_DQ); const bf16_t* DK = (const bf16_t*)(ws + WS_DK); const bf16_t* DV = (const bf16_t*)(ws + WS_DV);
    bf16_t* OG = (bf16_t*)(ws + WS_OG); float* LSE = (float*)(ws + WS_LSE);
    const int tid = tid_local(), lane = tid & 63, wid = tid >> 6  , fr = lane & 15, fq = lane >> 4, qq = fr >> 2, pp = lane & 3;
    LAS unsigned char* Kt = lds; LAS unsigned char* Vt = lds + 256 * KP * 2;
    const int vcu = (gridDim.x & 7) == 0 ? (int)((blockIdx.x & 7) * (gridDim.x >> 3) + (blockIdx.x >> 3)) : (int)blockIdx.x;
    for (int unit = vcu; unit < 2 * 3 * 8 * 64; unit += gridDim.x) {
        const int u64 = unit & 63, hh = (unit >> 6) & 7, g = (unit >> 9) % 3, bl = unit / 1536;
        const int r = 1 << (2 * g), nb = 64 >> (2 * g), rc = u64 / nb, n = u64 % nb;
        const int tb = bl * SEQ, cb = g * 1024 + hh * 128;
        {
            const int ch = tid & 15, r0 = tid >> 4;
            const bool hasprev = n > 0;
            const size_t rowstep = (size_t)32 * r * 3072;
            const bf16_t* kp = DK + (size_t)(tb + (128 * (n - 1) + r0) * r + rc) * 3072 + cb + ch * 8;
            const bf16_t* vp = DV + (size_t)(tb + (128 * (n - 1) + r0) * r + rc) * 3072 + cb + ch * 8;
            u32x4 kr[8];
#pragma unroll
            for (int i = 0; i < 4; ++i) kr[i] = (u32x4){0, 0, 0, 0};
            if (hasprev) {
#pragma unroll
                for (int i = 0; i < 4; ++i) kr[i] = *(const u32x4*)(kp + i * rowstep);
            }
#pragma unroll
            for (int i = 4; i < 8; ++i) kr[i] = *(const u32x4*)(kp + i * rowstep);
#pragma unroll
            for (int i = 0; i < 8; ++i) *(LAS u32x4*)(Kt + ((r0 + 32 * i) * KP + ch * 8) * 2) = kr[i];
#pragma unroll
            for (int i = 0; i < 4; ++i) kr[i] = (u32x4){0, 0, 0, 0};
            if (hasprev) {
#pragma unroll
                for (int i = 0; i < 4; ++i) kr[i] = *(const u32x4*)(vp + i * rowstep);
            }
#pragma unroll
            for (int i = 4; i < 8; ++i) kr[i] = *(const u32x4*)(vp + i * rowstep);
#pragma unroll
            for (int i = 0; i < 8; ++i) *(LAS u32x4*)(Vt + ((r0 + 32 * i) * KP + ch * 8) * 2) = kr[i];
        }
        bf16x8 qf[4];
        { const size_t tq = (size_t)(tb + (128 * n + 16 * wid + fr) * r + rc);
#pragma unroll
          for (int kk = 0; kk < 4; ++kk) qf[kk] = *(const bf16x8*)(DQ + tq * 3072 + cb + 32 * kk + 8 * fq); }
        __syncthreads();
        f32x4 sc[10];
#pragma unroll
        for (int i = 0; i < 10; ++i) {
            const int kt = wid + i, ktc = kt < 15 ? kt : 15;
            f32x4 acc = {0, 0, 0, 0};
#pragma unroll
            for (int kk = 0; kk < 4; ++kk) {
                const bf16x8 af = *(const LAS bf16x8*)(Kt + ((16 * ktc + fr) * KP + 32 * kk + 8 * fq) * 2);
                acc = MFMA16(af, qf[kk], acc);
            }
            sc[i] = acc;
        }
        const int qi = 16 * wid + fr;
        const int klo = (n > 0 || qi >= 128) ? qi : 128, khi = qi + 128 < 255 ? qi + 128 : 255;
        float mx = -3.0e38f;
#pragma unroll
        for (int i = 0; i < 10; ++i)
#pragma unroll
            for (int j = 0; j < 4; ++j) {
                const int kj = 16 * (wid + i) + 4 * fq + j;
                const int dlo = kj - klo, dhi = khi - kj;
                const int dm = (dlo < dhi ? dlo : dhi) >> 31;
                sc[i][j] = fmaf((float)dm, 3.0e38f, sc[i][j]);
                mx = fmaxf(mx, sc[i][j]);
            }
        mx = fmaxf(mx, __shfl_xor(mx, 16)); mx = fmaxf(mx, __shfl_xor(mx, 32));
        float den = 0.f;
#pragma unroll
        for (int i = 0; i < 10; ++i)
#pragma unroll
            for (int j = 0; j < 4; ++j) { const float p = __expf(sc[i][j] - mx); sc[i][j] = p; den += p; }
        den += __shfl_xor(den, 16); den += __shfl_xor(den, 32);
        f32x4 o[8];
#pragma unroll
        for (int dt = 0; dt < 8; ++dt) o[dt] = (f32x4){0, 0, 0, 0};
#pragma unroll
        for (int pi = 0; pi < 5; ++pi) {
            const int kta = wid + 2 * pi, ktb = kta + 1, ka = kta < 15 ? kta : 15, kb = ktb < 15 ? ktb : 15;
            bf16x8 pf;
            { const unsigned w0 = pk2(sc[2 * pi][0], sc[2 * pi][1]), w1 = pk2(sc[2 * pi][2], sc[2 * pi][3]), w2 = pk2(sc[2 * pi + 1][0], sc[2 * pi + 1][1]), w3 = pk2(sc[2 * pi + 1][2], sc[2 * pi + 1][3]);
              pf = __builtin_bit_cast(bf16x8, (u32x4){w0, w1, w2, w3}); }
#pragma unroll
            for (int dt = 0; dt < 8; ++dt) {
                const LAS unsigned char* va = Vt + ((16 * ka + 4 * fq + qq) * KP + 16 * dt + 4 * pp) * 2;
                const LAS unsigned char* vb = Vt + ((16 * kb + 4 * fq + qq) * KP + 16 * dt + 4 * pp) * 2;
                const bf16x8 bfr = cat8(tr4(va), tr4(vb));
                o[dt] = MFMA16(pf, bfr, o[dt]);
            }
        }
        const float lse_l = mx + __logf(den);
        if (fq == 0) LSE[(size_t)(tb + (128 * n + qi) * r + rc) * 24 + g * 8 + hh] = lse_l;
#pragma unroll
        for (int j = 0; j < 4; ++j) {
            const float dj = __shfl(den, 4 * fq + j);
            const float inv = fast_rcp(dj);
            const size_t tq = (size_t)(tb + (128 * n + 16 * wid + 4 * fq + j) * r + rc);
#pragma unroll
            for (int dt = 0; dt < 8; ++dt) OG[tq * 3072 + cb + 16 * dt + fr] = f2bf(o[dt][j] * inv);
        }
        __syncthreads();
    }
}
__device__ __forceinline__ void dil_merge(CArgs a, int half, int gw, int NGW, int lane) {
    const bf16_t* OG = (const bf16_t*)(a->ws + WS_OG); const float* LSE = (const float*)(a->ws + WS_LSE); bf16_t* OB = (bf16_t*)(a->ws + WS_OB);
    const int hh = lane >> 3, d0 = (lane & 7) * 16;
    for (int m = gw; m < TH; m += NGW) {
        const float l0 = LSE[(size_t)m * 24 + hh], l1 = LSE[(size_t)m * 24 + 8 + hh], l2 = LSE[(size_t)m * 24 + 16 + hh];
        const float mx = fmaxf(l0, fmaxf(l1, l2));
        float w0 = __expf(l0 - mx), w1 = __expf(l1 - mx), w2 = __expf(l2 - mx);
        const float inv = 1.0f / (w0 + w1 + w2); w0 *= inv; w1 *= inv; w2 *= inv;
        const bf16_t* p = OG + (size_t)m * 3072 + hh * 128 + d0;
        bf16_t* o = OB + (size_t)(half * TH + m) * 1024 + hh * 128 + d0;
#pragma unroll
        for (int q = 0; q < 2; ++q) {
            const u32x4 a0 = *(const u32x4*)(p + 8 * q), a1 = *(const u32x4*)(p + 1024 + 8 * q), a2 = *(const u32x4*)(p + 2048 + 8 * q);
            u32x4 w;
            w.x = pk2(w0 * bf_lo(a0.x) + w1 * bf_lo(a1.x) + w2 * bf_lo(a2.x), w0 * bf_hi(a0.x) + w1 * bf_hi(a1.x) + w2 * bf_hi(a2.x));
            w.y = pk2(w0 * bf_lo(a0.y) + w1 * bf_lo(a1.y) + w2 * bf_lo(a2.y), w0 * bf_hi(a0.y) + w1 * bf_hi(a1.y) + w2 * bf_hi(a2.y));
            w.z = pk2(w0 * bf_lo(a0.z) + w1 * bf_lo(a1.z) + w2 * bf_lo(a2.z), w0 * bf_hi(a0.z) + w1 * bf_hi(a1.z) + w2 * bf_hi(a2.z));
            w.w = pk2(w0 * bf_lo(a0.w) + w1 * bf_lo(a1.w) + w2 * bf_lo(a2.w), w0 * bf_hi(a0.w) + w1 * bf_hi(a1.w) + w2 * bf_hi(a2.w));
            *(u32x4*)(o + 8 * q) = w;
        }
    }
}

constexpr size_t WS_BAR = 512 * 1024;
__device__ __forceinline__ void grid_barrier(unsigned* bar, unsigned& gen, unsigned G) {
    asm volatile("s_waitcnt vmcnt(0) lgkmcnt(0)" ::: "memory");
    __syncthreads();
    ++gen;
    if (threadIdx.x == 0) {
        __builtin_amdgcn_fence(__ATOMIC_RELEASE, "agent");
        asm volatile("s_waitcnt vmcnt(0)" ::: "memory");
        if ((G & 7u) == 0u) {
            const unsigned x = blockIdx.x & 7u, per = G >> 3;
            unsigned* cnt1 = bar + 64 * (1 + x); unsigned* cnt2 = bar + 64 * 9; unsigned* rel = bar + 64 * (10 + x);
            const unsigned old = __hip_atomic_fetch_add(cnt1, 1u, __ATOMIC_RELAXED, __HIP_MEMORY_SCOPE_AGENT);
            if (old + 1u == gen * per) {
                __hip_atomic_fetch_add(cnt2, 1u, __ATOMIC_RELAXED, __HIP_MEMORY_SCOPE_AGENT);
                while (__hip_atomic_load(cnt2, __ATOMIC_RELAXED, __HIP_MEMORY_SCOPE_AGENT) < gen * 8u) __builtin_amdgcn_s_sleep(1);
                __hip_atomic_fetch_add(rel, 1u, __ATOMIC_RELAXED, __HIP_MEMORY_SCOPE_AGENT);
            } else {
                while (__hip_atomic_load(rel, __ATOMIC_RELAXED, __HIP_MEMORY_SCOPE_AGENT) < gen) __builtin_amdgcn_s_sleep(1);
            }
        } else {
            __hip_atomic_fetch_add(bar, 1u, __ATOMIC_RELAXED, __HIP_MEMORY_SCOPE_AGENT);
            const unsigned target = gen * G;
            while (__hip_atomic_load(bar, __ATOMIC_RELAXED, __HIP_MEMORY_SCOPE_AGENT) < target) __builtin_amdgcn_s_sleep(2);
        }
        __builtin_amdgcn_fence(__ATOMIC_ACQUIRE, "agent");
        asm volatile("s_waitcnt vmcnt(0)" ::: "memory");
    }
    __syncthreads();
}

#ifndef PH_MASK
#define PH_MASK 0xffffffffu
#endif
#define ON(k) (((PH_MASK) >> (k)) & 1u)
#ifndef GEMM_SP2
#define GEMM_SP2 true
#endif
#ifndef GEMM_ALIGN
#define GEMM_ALIGN true
#endif
__global__ void __launch_bounds__(512, 2) fwd_megakernel(Args a_by_value) {
    extern __shared__ __attribute__((aligned(16))) unsigned char lds_raw[];
    LAS unsigned char* lds = (LAS unsigned char*)lds_raw;
    cg::grid_group grid = cg::this_grid();
    const int tid = tid_local(), lane = tid & 63, wave = __builtin_amdgcn_readfirstlane(tid >> 6);
    const int G = gridDim.x, gw = blockIdx.x * 8 + wave, NGW = G * 8;
    const CArgs ap0 = (CArgs)__builtin_amdgcn_kernarg_segment_ptr();
    LAS float* scr = (LAS float*)(lds + wave * 16384);
#define PH_BEGIN const CArgs a = launder(ap0); unsigned char* const ws = a->ws; float* const mods = (float*)(ws + WS_MODS); (void)mods;
#define Wgu ((bf16_t*)(ws + WS_WGU))
#define Wd ((bf16_t*)(ws + WS_WD))
#define Win ((bf16_t*)(ws + WS_WIN))
#define Wa ((bf16_t*)(ws + WS_WA))
#define Wb ((bf16_t*)(ws + WS_WB))
#define Wo ((bf16_t*)(ws + WS_WO))
#define H ((bf16_t*)(ws + WS_H))
#define ACT ((bf16_t*)(ws + WS_ACT))
    using pg8::Gemm; using pg8::StaticOrder;
    unsigned bar_gen = 0;
    {
        unsigned char* w0 = launder(ap0)->ws;
        const int gid = (int)blockIdx.x * 512 + tid;
        if (gid < (NB * NMOD * D) / 4) ((u32x4*)(w0 + WS_MODS))[gid] = (u32x4){0, 0, 0, 0};
        if (blockIdx.x == 0) for (int i = tid; i < 64 * 20; i += 512) ((unsigned*)(w0 + WS_BAR))[i] = 0u;
        asm volatile("s_waitcnt vmcnt(0)" ::: "memory");
    }
    grid.sync();
#define GRID_SYNC() grid_barrier((unsigned*)(launder(ap0)->ws + WS_BAR), bar_gen, (unsigned)G)

    { PH_BEGIN
    if (ON(0)) for (int it = gw; it < 72 * 16; it += NGW) mods_item(a, mods, scr, it, lane);
    if (ON(0)) {
        constexpr int total = (D / 64) * (2 * FF / 32);
        for (int it = gw; it < total; it += NGW) { int r = it; tj(a->w_gu1, D, 2 * FF, Wgu, 0, 2 * FF, 0, 2, r, scr, lane); }
    }
    }
    GRID_SYNC();
    { PH_BEGIN
    if (ON(1)) modulate_rows(a->x, mods, 0, H, gw, NGW, lane);
    if (ON(1)) {
        constexpr int total = (FF / 64) * (D / 32) + (D / 64) * ((6144 + 32) / 32);
        for (int it = gw; it < total; it += NGW) {
            int r = it;
            if (tj(a->w_d1, FF, D, Wd, 0, D, 0, 0, r, scr, lane)) continue;
            tj(a->w_in, D, WIN_SRC, Win, WR_GLA, 6144 + 32, 0, 0, r, scr, lane);
        }
    }
    }
    GRID_SYNC();
    { PH_BEGIN
    if (ON(2)) { Gemm g{H, Wgu, T, 2 * FF, D}; StaticOrder S; S.init(T, 2 * FF, G, (int)blockIdx.x); EpiGU E{ACT};
      pg8::gemm_phase<EpiGU, StaticOrder, GEMM_ALIGN, GEMM_SP2>(lds, g, S, E); }
    }
    GRID_SYNC();
    { PH_BEGIN
    if (ON(3)) { Gemm g{ACT, Wd, T, D, FF}; StaticOrder S; S.init(T, D, G, (int)blockIdx.x); EpiRes E{a->x, a->out, mods + 2 * D, 0.5f};
      pg8::gemm_phase<EpiRes, StaticOrder, GEMM_ALIGN, GEMM_SP2>(lds, g, S, E); }
    }
    GRID_SYNC();
    { PH_BEGIN
    if (ON(4)) ln_rows(a->out, a->ln1_g, a->ln1_b, mods, 3, H, gw, NGW, lane);
    }
    GRID_SYNC();
    { PH_BEGIN
    if (ON(5)) { Gemm g{H, Win + (size_t)WR_GLA * D, T, 25 * 256, D}; StaticOrder S; S.init(T, 25 * 256, G, (int)blockIdx.x);
      EpiGla E{(bf16_t*)(ws + WS_Q), (bf16_t*)(ws + WS_K), (bf16_t*)(ws + WS_V), (bf16_t*)(ws + WS_R), (float*)(ws + WS_GLR)};
      pg8::gemm_phase<EpiGla, StaticOrder, GEMM_ALIGN, GEMM_SP2>(lds, g, S, E); }
    }
    GRID_SYNC();
    { PH_BEGIN
    if (ON(6)) gla_prep(a, lds);
    }
    GRID_SYNC();
    { PH_BEGIN
    if (ON(7)) {
        if (blockIdx.x < 128) gla_seq(a, lds);
        else {
            const int gw2 = (blockIdx.x - 128) * 8 + wave, NGW2 = (G - 128) * 8;
            constexpr int total = (D / 64) * ((3072 + 3072 + 7168) / 32) + (2048 / 64) * (D / 32) + (1024 / 64) * (D / 32) + (D / 64) * (D / 32) + (D / 64) * (2 * FF / 32) + (FF / 64) * (D / 32);
            for (int it = gw2; it < total; it += NGW2) {
                int r = it;
                if (tj(a->w_in, D, WIN_SRC, Win, WR_DQ, 3072, 6160, 1, r, scr, lane)) continue;
                if (tj(a->w_in, D, WIN_SRC, Win, WR_DK, 3072, 9232, 1, r, scr, lane)) continue;
                if (tj(a->w_in, D, WIN_SRC, Win, WR_DV, 3072 + 4096, 12304, 0, r, scr, lane)) continue;
                if (tj(a->w_a, 2048, D, Wa, 0, D, 0, 0, r, scr, lane)) continue;
                if (tj(a->w_b, 1024, D, Wb, 0, D, 0, 0, r, scr, lane)) continue;
                if (tj(a->w_o, D, D, Wo, 0, D, 0, 0, r, scr, lane)) continue;
                if (tj(a->w_gu2, D, 2 * FF, Wgu, 0, 2 * FF, 0, 2, r, scr, lane)) continue;
                tj(a->w_d2, FF, D, Wd, 0, D, 0, 0, r, scr, lane);
            }
        }
    }
    }
    GRID_SYNC();
    { PH_BEGIN
    if (ON(8)) gla_norm(a, gw, NGW, lane);
    if (ON(9)) rope_tables(a);
    }
    GRID_SYNC();
    for (int half = 0; half < 2; ++half) {
        { PH_BEGIN
        if (ON(11) && half == 1) dil_merge(a, 0, gw, NGW, lane);
        if (ON(9)) { Gemm g{H + (size_t)half * TH * D, Win + (size_t)WR_DQ * D, TH, 36 * 256, D}; StaticOrder S; S.init(TH, 36 * 256, G, (int)blockIdx.x);
          EpiDil E{(bf16_t*)(ws + WS_DQ), (bf16_t*)(ws + WS_DK), (bf16_t*)(ws + WS_DV), (const float*)(ws + WS_COS) + (size_t)half * TH * 64, (const float*)(ws + WS_SIN) + (size_t)half * TH * 64};
          pg8::gemm_phase<EpiDil, StaticOrder, GEMM_ALIGN, GEMM_SP2>(lds, g, S, E); }
        }
        GRID_SYNC();
        { PH_BEGIN
        if (ON(10)) dil_attn(a, lds);
        }
        GRID_SYNC();
    }
    { PH_BEGIN
    if (ON(11)) dil_merge(a, 1, gw, NGW, lane);
    if (ON(13)) { Gemm g{H, Win + (size_t)WR_GATE * D, T, 16 * 256, D}; StaticOrder S; S.init(T, 16 * 256, G, (int)blockIdx.x);
      EpiGates E{(bf16_t*)(ws + WS_SGA), (bf16_t*)(ws + WS_SGB)};
      pg8::gemm_phase<EpiGates, StaticOrder, GEMM_ALIGN, GEMM_SP2>(lds, g, S, E); }
    }
    GRID_SYNC();
    { PH_BEGIN
    if (ON(14)) { Gemm g{(const bf16_t*)(ws + WS_OA), Wa, T, D, 2048}; StaticOrder S; S.init(T, D, G, (int)blockIdx.x);
      EpiMul<false> E{(const bf16_t*)(ws + WS_SGA), (bf16_t*)(ws + WS_SGA)};
      pg8::gemm_phase<EpiMul<false>, StaticOrder, GEMM_ALIGN, GEMM_SP2>(lds, g, S, E); }
    }
    { PH_BEGIN
    if (ON(15)) { Gemm g{(const bf16_t*)(ws + WS_OB), Wb, T, D, 1024}; StaticOrder S; S.init(T, D, G, (int)blockIdx.x);
      EpiMul<true> E{(const bf16_t*)(ws + WS_SGB), (bf16_t*)(ws + WS_SGA)};
      pg8::gemm_phase<EpiMul<true>, StaticOrder, GEMM_ALIGN, GEMM_SP2>(lds, g, S, E); }
    }
    GRID_SYNC();
    { PH_BEGIN
    if (ON(16)) { Gemm g{(const bf16_t*)(ws + WS_SGA), Wo, T, D, D}; StaticOrder S; S.init(T, D, G, (int)blockIdx.x); EpiRes E{a->out, a->out, mods + 5 * D, 1.0f};
      pg8::gemm_phase<EpiRes, StaticOrder, GEMM_ALIGN, GEMM_SP2>(lds, g, S, E); }
    }
    GRID_SYNC();
    { PH_BEGIN
    if (ON(17)) ln_rows(a->out, a->ln2_g, a->ln2_b, mods, 6, H, gw, NGW, lane);
    }
    GRID_SYNC();
    { PH_BEGIN
    if (ON(18)) { Gemm g{H, Wgu, T, 2 * FF, D}; StaticOrder S; S.init(T, 2 * FF, G, (int)blockIdx.x); EpiGU E{ACT};
      pg8::gemm_phase<EpiGU, StaticOrder, GEMM_ALIGN, GEMM_SP2>(lds, g, S, E); }
    }
    GRID_SYNC();
    { PH_BEGIN
    if (ON(19)) { Gemm g{ACT, Wd, T, D, FF}; StaticOrder S; S.init(T, D, G, (int)blockIdx.x); EpiRes E{a->out, a->out, mods + 8 * D, 0.5f};
      pg8::gemm_phase<EpiRes, StaticOrder, GEMM_ALIGN, GEMM_SP2>(lds, g, S, E); }
    }
    GRID_SYNC();
    { PH_BEGIN
    if (ON(20)) ln_rows(a->out, a->ln3_g, a->ln3_b, mods, 0, nullptr, gw, NGW, lane);
    }
}

extern "C" void kernel_launch(void* const* d_in, const int* in_sizes, int n_in, void* d_out, int out_size, void* d_ws, size_t ws_size, hipStream_t stream) {
    static int grid = 0;
    if (grid == 0) {
        if (n_in != 22 || out_size != T * D || ws_size < WS_END) { fprintf(stderr, "kernel_launch: unexpected shapes: n_in %d out %d ws %zu\n", n_in, out_size, ws_size); grid = -1; return; }
        int dev = 0, cus = 0, per_cu = 0;
        hipGetDevice(&dev); hipDeviceGetAttribute(&cus, hipDeviceAttributeMultiprocessorCount, dev);
        hipFuncSetAttribute((const void*)fwd_megakernel, hipFuncAttributeMaxDynamicSharedMemorySize, LDS_BYTES);
        hipOccupancyMaxActiveBlocksPerMultiprocessor(&per_cu, (const void*)fwd_megakernel, 512, LDS_BYTES);
        (void)hipGetLastError();
        if (per_cu < 1) fprintf(stderr, "kernel_launch: occupancy query says %d blocks/CU\n", per_cu);
        grid = cus;
    }
    if (grid < 0) return;
    Args a{};
    a.x = (const float*)d_in[0]; a.c = (const float*)d_in[1]; a.pos = (const int*)d_in[2]; a.w_ada = (const float*)d_in[3]; a.b_ada = (const float*)d_in[4];
    a.ln1_g = (const float*)d_in[5]; a.ln1_b = (const float*)d_in[6]; a.w_gu1 = (const float*)d_in[7]; a.w_d1 = (const float*)d_in[8];
    a.w_in = (const float*)d_in[9]; a.w_alpha2 = (const float*)d_in[10]; a.b_alpha = (const float*)d_in[11]; a.gla_g = (const float*)d_in[12];
    a.w_a = (const float*)d_in[13]; a.w_b = (const float*)d_in[14]; a.w_o = (const float*)d_in[15]; a.ln2_g = (const float*)d_in[16]; a.ln2_b = (const float*)d_in[17];
    a.w_gu2 = (const float*)d_in[18]; a.w_d2 = (const float*)d_in[19]; a.ln3_g = (const float*)d_in[20]; a.ln3_b = (const float*)d_in[21];
    a.out = (float*)d_out; a.ws = (unsigned char*)d_ws;
    void* args[] = {&a};
    hipError_t e = hipLaunchCooperativeKernel((const void*)fwd_megakernel, dim3(grid), dim3(512), args, LDS_BYTES, stream);
    if (e != hipSuccess) fprintf(stderr, "kernel_launch: cooperative launch failed: %s (grid %d)\n", hipGetErrorString(e), grid);
}
```

```cpp
#include <hip/hip_runtime.h>
#include <hip/hip_cooperative_groups.h>
#include <cstdio>
#include <cstdint>
namespace cg = cooperative_groups;

#define LAS __attribute__((address_space(3)))
typedef unsigned short bf16_t;
typedef short bf16x8 __attribute__((ext_vector_type(8)));
typedef short s16x4 __attribute__((ext_vector_type(4)));
typedef float f32x4 __attribute__((ext_vector_type(4)));
typedef float f32x2 __attribute__((ext_vector_type(2)));
typedef unsigned u32x4 __attribute__((ext_vector_type(4)));
typedef unsigned u32x2 __attribute__((ext_vector_type(2)));

__device__ __forceinline__ int tid_local() { int t = threadIdx.x; asm volatile("" : "+v"(t)); return t; }

namespace pg8 {
constexpr int BM = 256, BK = 64, HALF = 128, HTB = HALF * BK * 2, STAGE_BYTES = 8 * HTB, NXCD = 8, WGM = 8;
__host__ __device__ __forceinline__ int lds_byte(int r, int c) { const int st = (r >> 4) * 2 + (c >> 5), rr = r & 15, cc = c & 31, ob = rr * 64 + cc * 2; return st * 1024 + (ob ^ (((ob >> 9) & 1) << 5)); }
__host__ __device__ __forceinline__ void stage_rc(int b, int& R, int& C) { const int st = b / 1024, sb = b % 1024, swz = sb ^ (((sb >> 9) & 1) << 5); R = (st >> 1) * 16 + swz / 64; C = (st & 1) * 32 + (swz % 64) / 2; }
__host__ __device__ __forceinline__ int perm32(int rho) { const int n = rho >> 4, i = rho & 15; return 8 * (i >> 2) + 4 * n + (i & 3); }
struct Unit { int pm, pn; };
struct Gemm { const bf16_t* A; const bf16_t* Bt; int M, N, K; };
struct StaticOrder {
    int nM, nN, nwg, G, c;
    __device__ void init(int M, int N, int G_, int c_) { nM = M / BM; nN = N / BM; nwg = nM * nN; G = G_; c = c_; }
    __device__ bool next(int i, Unit& u) const {
        const long L = (long)i * G + c; if (L >= nwg) return false;
        int wgid = (int)L; { const int q = nwg / NXCD, r = nwg % NXCD, xcd = wgid % NXCD, off = wgid / NXCD; wgid = (xcd < r ? xcd * (q + 1) : r * (q + 1) + (xcd - r) * q) + off; }
        const int nig = WGM * nN, gid = wgid / nig, fm = gid * WGM, gsz = (nM - fm) < WGM ? (nM - fm) : WGM;
        u.pm = fm + ((wgid % nig) % gsz); u.pn = (wgid % nig) / gsz; return true;
    }
    __device__ __forceinline__ void a_ready(const Unit&) const {}
    __device__ __forceinline__ void done(const Unit&) const {}
};
typedef float f32x2_t __attribute__((ext_vector_type(2)));
typedef __bf16 bf16x2_t __attribute__((ext_vector_type(2)));
__device__ __forceinline__ unsigned cvt_pk_bf16(float lo, float hi) { f32x2_t v = {lo, hi}; bf16x2_t b = __builtin_convertvector(v, bf16x2_t); return __builtin_bit_cast(unsigned, b); }

template <class Epi, class Sched, bool ALIGN_EPI = false, bool SP2 = false>
__device__ __forceinline__ void gemm_phase(LAS unsigned char* lds, const Gemm g, const Sched& S, const Epi& E) {
    const int tid = tid_local(), wid = __builtin_amdgcn_readfirstlane(tid >> 6), lane = tid & 63, wr = wid >> 2, wc = wid & 3, fr = lane & 15, fq = lane >> 4;
    const int K = g.K, nt = K / BK;
    unsigned voffA[2], voffB[2];
#pragma unroll
    for (int i = 0; i < 2; ++i) { int R, C; stage_rc(tid * 16 + i * 8192, R, C); const int Rb = Epi::PERM ? ((R & ~31) + perm32(R & 31)) : R;
        voffA[i] = (unsigned)(R * K + C) * 2u; voffB[i] = (unsigned)(Rb * K + C) * 2u; }
    const size_t kstep = (size_t)(BK * 2);
    const size_t hstep = (size_t)HALF * K * 2;
    const size_t tstep = 2 * hstep;
    const unsigned ldsw = (unsigned)wid * 1024u;
    const int aoff = lds_byte(wr * 64 + fr, fq * 8), boff = lds_byte(wc * 32 + fr, fq * 8);
#define PG8_SA(b, h) (((b) * 2 + (h)) * HTB)
#define PG8_SB(b, h) ((4 + (b) * 2 + (h)) * HTB)
#define PG8_STAGE(bufoff, gbase, voff) do { _Pragma("unroll") for (int _i = 0; _i < 2; ++_i) \
        __builtin_amdgcn_global_load_lds((const unsigned*)((const char*)(gbase) + (voff)[_i]), (LAS unsigned*)(lds + (bufoff) + ldsw + _i * 8192), 16, 0, 1); } while (0)
#define PG8_LDA(dst, b, h) do { _Pragma("unroll") for (int m = 0; m < 4; ++m) _Pragma("unroll") for (int k = 0; k < 2; ++k) dst[m][k] = *(const LAS bf16x8*)(lds + PG8_SA(b, h) + aoff + m * 2048 + k * 1024); } while (0)
#define PG8_LDB(dst, b, h) do { _Pragma("unroll") for (int n = 0; n < 2; ++n) _Pragma("unroll") for (int k = 0; k < 2; ++k) dst[n][k] = *(const LAS bf16x8*)(lds + PG8_SB(b, h) + boff + n * 2048 + k * 1024); } while (0)
#define PG8_MMA(ai, bj, At, Bt) do { __builtin_amdgcn_s_setprio(1); _Pragma("unroll") for (int m = 0; m < 4; ++m) _Pragma("unroll") for (int n = 0; n < 2; ++n) _Pragma("unroll") for (int k = 0; k < 2; ++k) \
        acc[ai][bj][m][n] = __builtin_amdgcn_mfma_f32_16x16x32_bf16(Bt[n][k], At[m][k], acc[ai][bj][m][n], 0, 0, 0); __builtin_amdgcn_s_setprio(0); } while (0)
#define PG8_WAIT_V(n) asm volatile("s_waitcnt vmcnt(" #n ")" ::: "memory")
#define PG8_WAIT_L(n) asm volatile("s_waitcnt lgkmcnt(" #n ")" ::: "memory")
#define PG8_BAR __builtin_amdgcn_s_barrier()
#define PG8_SCHED __builtin_amdgcn_sched_barrier(0)
    Unit cur, nxt; int ui = 0;
    if (!S.next(0, cur)) return;
    f32x4 acc[2][2][4][2];
#pragma unroll
    for (int a = 0; a < 2; ++a)
#pragma unroll
        for (int b = 0; b < 2; ++b)
#pragma unroll
            for (int m = 0; m < 4; ++m)
#pragma unroll
                for (int n = 0; n < 2; ++n) acc[a][b][m][n] = (f32x4){0.f, 0.f, 0.f, 0.f};
    bf16x8 At[4][2], B0[2][2], B1[2][2];
    const char* cA = (const char*)g.A + (size_t)cur.pm * tstep; const char* cB = (const char*)g.Bt + (size_t)cur.pn * tstep;
    S.a_ready(cur);
    if constexpr (SP2) {
        PG8_STAGE(PG8_SB(0, 0), cB, voffB); PG8_STAGE(PG8_SB(0, 1), cB + hstep, voffB); PG8_STAGE(PG8_SA(0, 0), cA, voffA); PG8_STAGE(PG8_SA(0, 1), cA + hstep, voffA);
        if (wr == 1) PG8_BAR;
        PG8_WAIT_V(2); PG8_BAR;
        PG8_STAGE(PG8_SB(1, 0), cB + kstep, voffB); PG8_STAGE(PG8_SA(1, 0), cA + kstep, voffA); PG8_STAGE(PG8_SB(1, 1), cB + hstep + kstep, voffB);
        PG8_WAIT_V(6); PG8_BAR;
    } else {
        PG8_STAGE(PG8_SB(0, 0), cB, voffB); PG8_STAGE(PG8_SA(0, 0), cA, voffA); PG8_STAGE(PG8_SB(0, 1), cB + hstep, voffB); PG8_STAGE(PG8_SA(0, 1), cA + hstep, voffA);
        if (wr == 1) PG8_BAR;
        PG8_WAIT_V(4); PG8_BAR;
        PG8_STAGE(PG8_SB(1, 0), cB + kstep, voffB); PG8_STAGE(PG8_SA(1, 0), cA + kstep, voffA); PG8_STAGE(PG8_SB(1, 1), cB + hstep + kstep, voffB);
        PG8_WAIT_V(6); PG8_BAR;
    }
    for (;;) {
        const bool has_next = S.next(ui + 1, nxt);
        const char* nA = has_next ? (const char*)g.A + (size_t)nxt.pm * tstep : cA; const char* nB = has_next ? (const char*)g.Bt + (size_t)nxt.pn * tstep : cB;
        for (int t = 0; t < nt; t += 2) {
            const bool last = (t == nt - 2);
            const char* a1 = cA + (size_t)(t + 1) * kstep;
            const char* a2 = last ? nA : cA + (size_t)(t + 2) * kstep; const char* b2 = last ? nB : cB + (size_t)(t + 2) * kstep;
            const char* a3 = a2 + kstep; const char* b3 = b2 + kstep;
            if (last && has_next) S.a_ready(nxt);
            if constexpr (SP2) {
            PG8_LDB(B0, 0, 0); PG8_LDB(B1, 0, 1); PG8_SCHED; PG8_LDA(At, 0, 0); PG8_STAGE(PG8_SA(1, 1), a1 + hstep, voffA);
            PG8_WAIT_V(8); PG8_WAIT_L(0); PG8_BAR; PG8_MMA(0, 0, At, B0); PG8_MMA(0, 1, At, B1); PG8_BAR; PG8_SCHED;
            PG8_LDA(At, 0, 1); PG8_STAGE(PG8_SB(0, 0), b2, voffB); PG8_STAGE(PG8_SB(0, 1), b2 + hstep, voffB); PG8_STAGE(PG8_SA(0, 0), a2, voffA);
            PG8_WAIT_V(8); PG8_WAIT_L(0); PG8_BAR; PG8_MMA(1, 0, At, B0); PG8_MMA(1, 1, At, B1); PG8_BAR; PG8_SCHED;
            PG8_LDB(B0, 1, 0); PG8_LDB(B1, 1, 1); PG8_SCHED; PG8_LDA(At, 1, 0); PG8_STAGE(PG8_SA(0, 1), a2 + hstep, voffA);
            PG8_WAIT_V(8); PG8_WAIT_L(0); PG8_BAR; PG8_MMA(0, 0, At, B0); PG8_MMA(0, 1, At, B1); PG8_BAR; PG8_SCHED;
            PG8_LDA(At, 1, 1); PG8_STAGE(PG8_SB(1, 0), b3, voffB); PG8_STAGE(PG8_SB(1, 1), b3 + hstep, voffB); PG8_STAGE(PG8_SA(1, 0), a3, voffA);
            PG8_WAIT_V(8); PG8_WAIT_L(0); PG8_BAR; PG8_MMA(1, 0, At, B0); PG8_MMA(1, 1, At, B1); PG8_BAR; PG8_SCHED;
            } else {
            PG8_LDB(B0, 0, 0); PG8_SCHED; PG8_LDA(At, 0, 0); PG8_STAGE(PG8_SA(1, 1), a1 + hstep, voffA);
            PG8_WAIT_L(8); PG8_BAR; PG8_WAIT_L(0); PG8_MMA(0, 0, At, B0); PG8_BAR; PG8_SCHED;
            PG8_LDB(B1, 0, 1); PG8_STAGE(PG8_SB(0, 0), b2, voffB);
            PG8_BAR; PG8_WAIT_L(0); PG8_MMA(0, 1, At, B1); PG8_BAR;
            PG8_LDA(At, 0, 1); PG8_STAGE(PG8_SA(0, 0), a2, voffA);
            PG8_BAR; PG8_WAIT_L(0); PG8_MMA(1, 0, At, B0); PG8_BAR; PG8_SCHED;
            PG8_STAGE(PG8_SB(0, 1), b2 + hstep, voffB);
            PG8_WAIT_V(6); PG8_BAR; PG8_MMA(1, 1, At, B1); PG8_BAR;
            PG8_LDB(B0, 1, 0); PG8_SCHED; PG8_LDA(At, 1, 0); PG8_STAGE(PG8_SA(0, 1), a2 + hstep, voffA);
            PG8_WAIT_L(8); PG8_BAR; PG8_WAIT_L(0); PG8_MMA(0, 0, At, B0); PG8_BAR; PG8_SCHED;
            PG8_LDB(B1, 1, 1); PG8_STAGE(PG8_SB(1, 0), b3, voffB);
            PG8_BAR; PG8_WAIT_L(0); PG8_MMA(0, 1, At, B1); PG8_BAR;
            PG8_LDA(At, 1, 1); PG8_STAGE(PG8_SA(1, 0), a3, voffA);
            PG8_BAR; PG8_WAIT_L(0); PG8_MMA(1, 0, At, B0); PG8_BAR; PG8_SCHED;
            PG8_STAGE(PG8_SB(1, 1), b3 + hstep, voffB);
            PG8_WAIT_V(6); PG8_BAR; PG8_MMA(1, 1, At, B1); PG8_BAR;
            }
        }
        if constexpr (ALIGN_EPI) { if (wr == 0) PG8_BAR; }
        E(acc, cur, wr, wc, fr, fq);
        if (!has_next) break;
#pragma unroll
        for (int a = 0; a < 2; ++a)
#pragma unroll
            for (int b = 0; b < 2; ++b)
#pragma unroll
                for (int m = 0; m < 4; ++m)
#pragma unroll
                    for (int n = 0; n < 2; ++n) acc[a][b][m][n] = (f32x4){0.f, 0.f, 0.f, 0.f};
        cur = nxt; cA = nA; cB = nB; ++ui;
        if constexpr (ALIGN_EPI) { if (wr == 1) PG8_BAR; }
    }
    PG8_WAIT_V(0);
    if constexpr (!ALIGN_EPI) { if (wr == 0) PG8_BAR; }
    PG8_BAR;
#undef PG8_SA
#undef PG8_SB
#undef PG8_STAGE
#undef PG8_LDA
#undef PG8_LDB
#undef PG8_MMA
#undef PG8_WAIT_V
#undef PG8_WAIT_L
#undef PG8_BAR
#undef PG8_SCHED
}
}

constexpr int NB = 4, SEQ = 8192, T = NB * SEQ, D = 2048, FF = 5632, NMOD = 9;
constexpr int TH = T / 2;
constexpr float LN_EPS = 1e-5f;
constexpr float DN_ALPHA = 1.189207115002721f;
constexpr int WIN_SRC = 19472;
constexpr int WIN_ROWS = 77 * 256;
constexpr int WR_GLA = 0, WR_GLR = 6144, WR_DQ = 6400, WR_DK = 9472, WR_DV = 12544, WR_GATE = 15616;

constexpr size_t MiB = 1u << 20;
constexpr size_t WS_MODS = 0;
constexpr size_t CTL_ZERO_BYTES = 1 * MiB;
constexpr size_t WS_GLR = 1 * MiB;
constexpr size_t WS_AIN = 3 * MiB;
constexpr size_t WS_COS = 3 * MiB, WS_SIN = 11 * MiB;
constexpr size_t WS_DEC = 19 * MiB;
constexpr size_t WS_LSE = 21 * MiB;
constexpr size_t WS_WGU = 23 * MiB;
constexpr size_t WS_WD = 67 * MiB;
constexpr size_t WS_WIN = 89 * MiB;
constexpr size_t WS_WA = 166 * MiB, WS_WB = 174 * MiB, WS_WO = 178 * MiB;
constexpr size_t WS_H = 186 * MiB;
constexpr size_t WS_ACT = 314 * MiB;
constexpr size_t WS_Q = 314 * MiB, WS_K = 378 * MiB, WS_V = 442 * MiB, WS_R = 570 * MiB, WS_ORAW = 698 * MiB;
constexpr size_t WS_OA = 314 * MiB;
constexpr size_t WS_DQ = 442 * MiB, WS_DK = 538 * MiB, WS_DV = 634 * MiB;
constexpr size_t WS_OB = 730 * MiB;
constexpr size_t WS_OG = 794 * MiB;
constexpr size_t WS_SGA = 442 * MiB, WS_SGB = 570 * MiB;
constexpr size_t WS_END = 954 * MiB;

constexpr int LDS_BYTES = 147456;

struct Args {
    const float* x; const float* c; const int* pos; const float* w_ada; const float* b_ada;
    const float* ln1_g; const float* ln1_b; const float* w_gu1; const float* w_d1;
    const float* w_in; const float* w_alpha2; const float* b_alpha; const float* gla_g;
    const float* w_a; const float* w_b; const float* w_o; const float* ln2_g; const float* ln2_b;
    const float* w_gu2; const float* w_d2; const float* ln3_g; const float* ln3_b;
    float* out; unsigned char* ws;
};

typedef const Args __attribute__((address_space(4)))* CArgs;
__device__ __forceinline__ CArgs launder(CArgs p) { asm volatile("" : "+s"(p)); return p; }

__device__ __forceinline__ unsigned pk2(float lo, float hi) { return pg8::cvt_pk_bf16(lo, hi); }
__device__ __forceinline__ float bf_lo(unsigned w) { return __uint_as_float(w << 16); }
__device__ __forceinline__ float bf_hi(unsigned w) { return __uint_as_float(w & 0xffff0000u); }
__device__ __forceinline__ float bf2f(bf16_t h) { return __uint_as_float(((unsigned)h) << 16); }
__device__ __forceinline__ bf16_t f2bf(float f) { unsigned u = __float_as_uint(f); return (bf16_t)((u + 0x7fffu + ((u >> 16) & 1u)) >> 16); }
__device__ __forceinline__ float fast_rcp(float x) { return __builtin_amdgcn_rcpf(x); }
__device__ __forceinline__ float sigmoidf_(float x) { return fast_rcp(1.0f + __expf(-x)); }
__device__ __forceinline__ float siluf_(float x) { return x * sigmoidf_(x); }
__device__ __forceinline__ float wave_sum(float v) {
#pragma unroll
    for (int o = 1; o < 64; o <<= 1) v += __shfl_xor(v, o);
    return v;
}
__device__ __forceinline__ s16x4 tr4(const LAS unsigned char* p) { return __builtin_bit_cast(s16x4, __builtin_amdgcn_ds_read_tr16_b64_v4i16((LAS s16x4*)p)); }
__device__ __forceinline__ bf16x8 cat8(s16x4 a, s16x4 b) { return (bf16x8){a[0], a[1], a[2], a[3], b[0], b[1], b[2], b[3]}; }
#define MFMA16(a, b, c) __builtin_amdgcn_mfma_f32_16x16x32_bf16((a), (b), (c), 0, 0, 0)

struct EpiGU {
    static constexpr bool PERM = true;
    bf16_t* O;
    __device__ __forceinline__ void operator()(const f32x4 (&acc)[2][2][4][2], const pg8::Unit& u, int wr, int wc, int fr, int fq) const {
        const int row0 = u.pm * 256 + wr * 64 + fr, col0 = u.pn * 128 + wc * 32 + 8 * fq;
#pragma unroll
        for (int ai = 0; ai < 2; ++ai)
#pragma unroll
            for (int m = 0; m < 4; ++m) {
                const f32x4 g0 = acc[ai][0][m][0], g1 = acc[ai][0][m][1], u0 = acc[ai][1][m][0], u1 = acc[ai][1][m][1];
                u32x4 w;
                w.x = pk2(siluf_(g0[0]) * u0[0], siluf_(g0[1]) * u0[1]); w.y = pk2(siluf_(g0[2]) * u0[2], siluf_(g0[3]) * u0[3]);
                w.z = pk2(siluf_(g1[0]) * u1[0], siluf_(g1[1]) * u1[1]); w.w = pk2(siluf_(g1[2]) * u1[2], siluf_(g1[3]) * u1[3]);
                *(u32x4*)(O + (size_t)(row0 + ai * 128 + m * 16) * FF + col0) = w;
            }
    }
};
struct EpiRes {
    static constexpr bool PERM = false;
    const float* res; float* out; const float* gate; float gs;
    __device__ __forceinline__ void operator()(const f32x4 (&acc)[2][2][4][2], const pg8::Unit& u, int wr, int wc, int fr, int fq) const {
        const int row0 = u.pm * 256 + wr * 64 + fr, col0 = u.pn * 256 + wc * 32 + 4 * fq;
        const float* gp = gate + (size_t)(u.pm >> 5) * (NMOD * D) + col0;
        f32x4 gv[2][2];
#pragma unroll
        for (int bj = 0; bj < 2; ++bj)
#pragma unroll
            for (int n = 0; n < 2; ++n) gv[bj][n] = *(const f32x4*)(gp + bj * 128 + n * 16) * gs;
#pragma unroll
        for (int ai = 0; ai < 2; ++ai)
#pragma unroll
            for (int m = 0; m < 4; ++m) {
                const size_t off = (size_t)(row0 + ai * 128 + m * 16) * D + col0;
#pragma unroll
                for (int bj = 0; bj < 2; ++bj)
#pragma unroll
                    for (int n = 0; n < 2; ++n) {
                        const f32x4 r = *(const f32x4*)(res + off + bj * 128 + n * 16);
                        *(f32x4*)(out + off + bj * 128 + n * 16) = r * DN_ALPHA + gv[bj][n] * acc[ai][bj][m][n];
                    }
                if (m & 1) asm volatile("" ::: "memory");
            }
    }
};
__device__ __forceinline__ void store8(bf16_t* p, const f32x4& a, const f32x4& b) {
    u32x4 w; w.x = pk2(a[0], a[1]); w.y = pk2(a[2], a[3]); w.z = pk2(b[0], b[1]); w.w = pk2(b[2], b[3]);
    *(u32x4*)p = w;
}
struct EpiGla {
    static constexpr bool PERM = true;
    bf16_t *Q, *Kk, *V, *R; float* GLR;
    __device__ __forceinline__ void operator()(const f32x4 (&acc)[2][2][4][2], const pg8::Unit& u, int wr, int wc, int fr, int fq) const {
        const int row0 = u.pm * 256 + wr * 64 + fr;
        if (u.pn < 24) {
            bf16_t* base; int ldc, colt;
            if (u.pn < 4) { base = Q; ldc = 1024; colt = u.pn * 256; }
            else if (u.pn < 8) { base = Kk; ldc = 1024; colt = (u.pn - 4) * 256; }
            else if (u.pn < 16) { base = V; ldc = 2048; colt = (u.pn - 8) * 256; }
            else { base = R; ldc = 2048; colt = (u.pn - 16) * 256; }
            const int col0 = colt + wc * 32 + 8 * fq;
#pragma unroll
            for (int ai = 0; ai < 2; ++ai)
#pragma unroll
                for (int m = 0; m < 4; ++m) {
                    bf16_t* rowp = base + (size_t)(row0 + ai * 128 + m * 16) * ldc + col0;
#pragma unroll
                    for (int bj = 0; bj < 2; ++bj) store8(rowp + bj * 128, acc[ai][bj][m][0], acc[ai][bj][m][1]);
                }
        } else if (wc == 0 && fq < 2) {
#pragma unroll
            for (int ai = 0; ai < 2; ++ai)
#pragma unroll
                for (int m = 0; m < 4; ++m) {
                    float* rowp = GLR + (size_t)(row0 + ai * 128 + m * 16) * 16 + 8 * fq;
                    *(f32x4*)rowp = acc[ai][0][m][0]; *(f32x4*)(rowp + 4) = acc[ai][0][m][1];
                }
        }
    }
};
struct EpiDil {
    static constexpr bool PERM = true;
    bf16_t *DQ, *DK, *DV; const float* cosT; const float* sinT;
    __device__ __forceinline__ void operator()(const f32x4 (&acc)[2][2][4][2], const pg8::Unit& u, int wr, int wc, int fr, int fq) const {
        const int row0 = u.pm * 256 + wr * 64 + fr;
        const int seg = u.pn / 12, colt = (u.pn - seg * 12) * 256;
        bf16_t* base = DQ + (size_t)seg * ((size_t)TH * 3072);
        const int col0 = colt + wc * 32 + 8 * fq;
        if (seg == 2) {
#pragma unroll
            for (int ai = 0; ai < 2; ++ai)
#pragma unroll
                for (int m = 0; m < 4; ++m) {
                    bf16_t* rowp = base + (size_t)(row0 + ai * 128 + m * 16) * 3072 + col0;
#pragma unroll
                    for (int bj = 0; bj < 2; ++bj) store8(rowp + bj * 128, acc[ai][bj][m][0], acc[ai][bj][m][1]);
                }
        } else {
            const float sc = seg == 0 ? 0.08838834764831845f : 1.0f;
            const int g4 = 4 * (4 * wc + fq);
#pragma unroll
            for (int ai = 0; ai < 2; ++ai)
#pragma unroll
                for (int m = 0; m < 4; ++m) {
                    const int row = row0 + ai * 128 + m * 16;
                    const f32x4 c4 = *(const f32x4*)(cosT + (size_t)row * 64 + g4) * sc, s4 = *(const f32x4*)(sinT + (size_t)row * 64 + g4) * sc;
                    bf16_t* rowp = base + (size_t)row * 3072 + col0;
#pragma unroll
                    for (int bj = 0; bj < 2; ++bj) {
                        const f32x4 x1 = acc[ai][bj][m][0], x2 = acc[ai][bj][m][1];
                        store8(rowp + bj * 128, x1 * c4 - x2 * s4, x2 * c4 + x1 * s4);
                    }
                    asm volatile("" ::: "memory");
                }
        }
    }
};
struct EpiGates {
    static constexpr bool PERM = true;
    bf16_t *SGA, *SGB;
    __device__ __forceinline__ void operator()(const f32x4 (&acc)[2][2][4][2], const pg8::Unit& u, int wr, int wc, int fr, int fq) const {
        const int row0 = u.pm * 256 + wr * 64 + fr;
        bf16_t* base = u.pn < 8 ? SGA : SGB;
        const int col0 = (u.pn & 7) * 256 + wc * 32 + 8 * fq;
#pragma unroll
        for (int ai = 0; ai < 2; ++ai)
#pragma unroll
            for (int m = 0; m < 4; ++m) {
                bf16_t* rowp = base + (size_t)(row0 + ai * 128 + m * 16) * D + col0;
#pragma unroll
                for (int bj = 0; bj < 2; ++bj) {
                    f32x4 a = acc[ai][bj][m][0], b = acc[ai][bj][m][1];
#pragma unroll
                    for (int j = 0; j < 4; ++j) { a[j] = sigmoidf_(a[j]); b[j] = sigmoidf_(b[j]); }
                    store8(rowp + bj * 128, a, b);
                }
            }
    }
};
template <bool ADD> struct EpiMul {
    static constexpr bool PERM = true;
    const bf16_t* gate; bf16_t* io;
    __device__ __forceinline__ void operator()(const f32x4 (&acc)[2][2][4][2], const pg8::Unit& u, int wr, int wc, int fr, int fq) const {
        const int row0 = u.pm * 256 + wr * 64 + fr, col0 = u.pn * 256 + wc * 32 + 8 * fq;
#pragma unroll
        for (int ai = 0; ai < 2; ++ai)
#pragma unroll
            for (int m = 0; m < 4; ++m) {
                const size_t off = (size_t)(row0 + ai * 128 + m * 16) * D + col0;
#pragma unroll
                for (int bj = 0; bj < 2; ++bj) {
                    const u32x4 gw = *(const u32x4*)(gate + off + bj * 128);
                    f32x4 a = acc[ai][bj][m][0], b = acc[ai][bj][m][1];
                    a[0] *= bf_lo(gw.x); a[1] *= bf_hi(gw.x); a[2] *= bf_lo(gw.y); a[3] *= bf_hi(gw.y);
                    b[0] *= bf_lo(gw.z); b[1] *= bf_hi(gw.z); b[2] *= bf_lo(gw.w); b[3] *= bf_hi(gw.w);
                    if (ADD) {
                        const u32x4 tw = *(const u32x4*)(io + off + bj * 128);
                        a[0] += bf_lo(tw.x); a[1] += bf_hi(tw.x); a[2] += bf_lo(tw.y); a[3] += bf_hi(tw.y);
                        b[0] += bf_lo(tw.z); b[1] += bf_hi(tw.z); b[2] += bf_lo(tw.w); b[3] += bf_hi(tw.w);
                    }
                    store8(io + off + bj * 128, a, b);
                }
            }
    }
};

__device__ __forceinline__ void mods_item(CArgs a, float* mods, LAS float* scr, int item, int lane) {
    const int cg_ = item % 72, kc = item / 72, k0 = kc * 128, col = cg_ * 256 + 4 * lane;
#pragma unroll
    for (int i = 0; i < 8; ++i) { const int e = lane + 64 * i, b = e >> 7, kk = e & 127; scr[e] = siluf_(a->c[b * D + k0 + kk]); }
    asm volatile("s_waitcnt lgkmcnt(0)" ::: "memory");
    f32x4 s0 = {0, 0, 0, 0}, s1 = s0, s2 = s0, s3 = s0;
    const float* wp = a->w_ada + (size_t)k0 * (NMOD * D) + col;
#pragma unroll 8
    for (int kk = 0; kk < 128; ++kk) {
        const f32x4 w = *(const f32x4*)(wp + (size_t)kk * (NMOD * D));
        s0 += w * scr[kk]; s1 += w * scr[128 + kk]; s2 += w * scr[256 + kk]; s3 += w * scr[384 + kk];
    }
    if (kc == 0) { const f32x4 bb = *(const f32x4*)(a->b_ada + col); s0 += bb; s1 += bb; s2 += bb; s3 += bb; }
#pragma unroll
    for (int j = 0; j < 4; ++j) {
        atomicAdd(mods + 0 * NMOD * D + col + j, s0[j]); atomicAdd(mods + 1 * NMOD * D + col + j, s1[j]);
        atomicAdd(mods + 2 * NMOD * D + col + j, s2[j]); atomicAdd(mods + 3 * NMOD * D + col + j, s3[j]);
    }
    asm volatile("s_waitcnt lgkmcnt(0)" ::: "memory");
}
__device__ __forceinline__ int srccol(int mode, int n, int src0) {
    if (mode == 0) return src0 + n;
    if (mode == 1) { const int head = n >> 7, p = n & 127, g = p >> 3, nn = (p >> 2) & 1, j = p & 3; return src0 + head * 128 + 4 * g + j + 64 * nn; }
    const int pn = n >> 8, rr = n & 255; return rr < 128 ? pn * 128 + rr : FF + pn * 128 + rr - 128;
}
__device__ __forceinline__ void transpose_item(const float* W, int K, int N, bf16_t* WT, int dst0, int src0, int mode, int nblk, LAS float* scr, int item, int lane) {
    const int kb = item / nblk, nb = item % nblk, k0 = 64 * kb, n0 = 32 * nb;
    const int sc = srccol(mode, n0 + (lane & 31), src0);
#pragma unroll 8
    for (int i = 0; i < 32; ++i) { const int kk = 2 * i + (lane >> 5); scr[kk * 33 + (lane & 31)] = W[(size_t)(k0 + kk) * N + sc]; }
    asm volatile("s_waitcnt lgkmcnt(0)" ::: "memory");
    const int c = lane & 7;
#pragma unroll
    for (int j = 0; j < 4; ++j) { const int n = (lane >> 3) + 8 * j; const LAS float* s = scr + (8 * c) * 33 + n;
        u32x4 o; o.x = pk2(s[0 * 33], s[1 * 33]); o.y = pk2(s[2 * 33], s[3 * 33]); o.z = pk2(s[4 * 33], s[5 * 33]); o.w = pk2(s[6 * 33], s[7 * 33]);
        *(u32x4*)(WT + (size_t)(dst0 + n0 + n) * K + k0 + 8 * c) = o; }
    asm volatile("s_waitcnt lgkmcnt(0)" ::: "memory");
}
__device__ __forceinline__ bool tj(const float* W, int K, int N, bf16_t* WT, int dst0, int nrows, int src0, int mode, int& r, LAS float* scr, int lane) {
    const int cnt = (K / 64) * (nrows / 32);
    if (r < cnt) { transpose_item(W, K, N, WT, dst0, src0, mode, nrows / 32, scr, r, lane); return true; }
    r -= cnt; return false;
}

__device__ __forceinline__ void modulate_rows(const float* x, const float* mods, int ch_shift, bf16_t* h, int gw, int NGW, int lane) {
    for (int m = gw; m < T; m += NGW) {
        const float* mp = mods + (size_t)(m / SEQ) * (NMOD * D) + ch_shift * D;
        const f32x4* xr = (const f32x4*)(x + (size_t)m * D) + lane;
        u32x2* o8 = (u32x2*)(h + (size_t)m * D) + lane;
#pragma unroll
        for (int j = 0; j < 8; ++j) {
            const f32x4 v = __builtin_nontemporal_load(xr + 64 * j), sh = ((const f32x4*)mp)[lane + 64 * j], sc = ((const f32x4*)(mp + D))[lane + 64 * j];
            const f32x4 r = v * (sc + 1.0f) + sh;
            u32x2 w; w.x = pk2(r[0], r[1]); w.y = pk2(r[2], r[3]); o8[64 * j] = w;
        }
    }
}
__device__ __forceinline__ void ln_rows(float* y, const float* g, const float* bta, const float* mods, int ch_shift, bf16_t* h, int gw, int NGW, int lane) {
    for (int m = gw; m < T; m += NGW) {
        f32x4* yr = (f32x4*)(y + (size_t)m * D) + lane;
        f32x4 v[8]; float s = 0.f;
#pragma unroll
        for (int j = 0; j < 8; ++j) { v[j] = __builtin_nontemporal_load(yr + 64 * j); s += (v[j][0] + v[j][1]) + (v[j][2] + v[j][3]); }
        const float mean = wave_sum(s) * (1.f / D); float s2 = 0.f;
#pragma unroll
        for (int j = 0; j < 8; ++j) { v[j] = v[j] - mean; s2 += (v[j][0] * v[j][0] + v[j][1] * v[j][1]) + (v[j][2] * v[j][2] + v[j][3] * v[j][3]); }
        const float rstd = 1.f / sqrtf(wave_sum(s2) * (1.f / D) + LN_EPS);
#pragma unroll
        for (int j = 0; j < 8; ++j) {
            const f32x4 gg = ((const f32x4*)g)[lane + 64 * j], bb = ((const f32x4*)bta)[lane + 64 * j];
            v[j] = v[j] * rstd * gg + bb; __builtin_nontemporal_store(v[j], yr + 64 * j);
        }
        if (h) {
            const float* mp = mods + (size_t)(m / SEQ) * (NMOD * D) + ch_shift * D;
            u32x2* o8 = (u32x2*)(h + (size_t)m * D) + lane;
#pragma unroll
            for (int j = 0; j < 8; ++j) {
                const f32x4 sh = ((const f32x4*)mp)[lane + 64 * j], sc = ((const f32x4*)(mp + D))[lane + 64 * j];
                const f32x4 r = v[j] * (sc + 1.0f) + sh;
                u32x2 w; w.x = pk2(r[0], r[1]); w.y = pk2(r[2], r[3]); o8[64 * j] = w;
            }
        }
    }
}

constexpr int GP = 264;
constexpr int VP = 72;
__device__ __forceinline__ void gla_prep(CArgs a, LAS unsigned char* lds) {
    unsigned char* ws = a->ws;
    bf16_t* Q = (bf16_t*)(ws + WS_Q); bf16_t* Kk = (bf16_t*)(ws + WS_K); const float* GLR = (const float*)(ws + WS_GLR);
    bf16_t* AIN = (bf16_t*)(ws + WS_AIN); float* DEC = (float*)(ws + WS_DEC);
    const int tid = tid_local(), lane = tid & 63, wid = __builtin_amdgcn_readfirstlane(tid >> 6), fr = lane & 15, fq = lane >> 4;
    LAS unsigned char* Qd = lds; LAS unsigned char* Ki = lds + 64 * GP * 2; LAS float* tot = (LAS float*)(lds + 2 * 64 * GP * 2);
    const int dk = tid & 255, half = __builtin_amdgcn_readfirstlane(tid >> 8);
    for (int unit = blockIdx.x; unit < NB * 4 * 128; unit += gridDim.x) {
        const int c = unit & 127, bh = unit >> 7, h = bh & 3, b = bh >> 2;
        const int t0 = b * SEQ + c * 64;
        LAS float* glr_l = (LAS float*)(lds + 2 * 64 * GP * 2 + 2048);
        if (tid < 256) *(LAS f32x4*)(glr_l + tid * 4) = *(const f32x4*)(GLR + (size_t)t0 * 16 + tid * 4);
        float w2[16];
#pragma unroll
        for (int r = 0; r < 16; ++r) w2[r] = a->w_alpha2[r * 1024 + h * 256 + dk];
        const float ba = a->b_alpha[h * 256 + dk];
        float la[32], qv[32], kv[32]; float run = 0.f;
#pragma unroll
        for (int i = 0; i < 32; ++i) {
            const size_t gi = (size_t)(t0 + half * 32 + i) * 1024 + h * 256 + dk;
            qv[i] = bf2f(Q[gi]); kv[i] = bf2f(Kk[gi]);
        }
        __syncthreads();
#pragma unroll
        for (int i = 0; i < 32; ++i) {
            const LAS f32x4* gp = (const LAS f32x4*)(glr_l + (half * 32 + i) * 16);
            const f32x4 g0 = gp[0], g1 = gp[1], g2 = gp[2], g3 = gp[3];
            float z = ba;
#pragma unroll
            for (int j = 0; j < 4; ++j) { z += g0[j] * w2[j]; z += g1[j] * w2[4 + j]; z += g2[j] * w2[8 + j]; z += g3[j] * w2[12 + j]; }
            const float ls = fminf(z, 0.f) - __logf(1.0f + __expf(-fabsf(z)));
            run += ls * (1.0f / 16.0f); la[i] = run;
        }
        tot[half * 256 + dk] = run;
        __syncthreads();
        const float t0s = tot[dk], t1s = tot[256 + dk];
        const float boff = half ? t0s : 0.f, blast = t0s + t1s, eblast = __expf(blast);
        if (half == 0) DEC[(size_t)unit * 256 + dk] = eblast;
        unsigned kew[16]; float kef_prev = 0.f;
#pragma unroll
        for (int i = 0; i < 32; ++i) {
            const int s = half * 32 + i;
            const float eb = __expf(boff + la[i]);
            const float kif = kv[i] * fast_rcp(eb);
            const bf16_t qd = f2bf(qv[i] * eb * 0.0625f), ki = f2bf(kif);
            *(LAS bf16_t*)(Qd + (s * GP + dk) * 2) = qd; *(LAS bf16_t*)(Ki + (s * GP + dk) * 2) = ki;
            const float kef = kif * eblast;
            if (i & 1) kew[i >> 1] = pk2(kef_prev, kef);
            kef_prev = kef;
        }
        {
            const int jj = (dk >> 4) * 2 + half;
#pragma unroll
            for (int v = 0; v < 4; ++v) { const int l = v * 16 + (dk & 15);
                *(u32x4*)(Kk + (size_t)(t0 + 2 * jj + (l >> 5)) * 1024 + h * 256 + (l & 31) * 8) = (u32x4){kew[4 * v], kew[4 * v + 1], kew[4 * v + 2], kew[4 * v + 3]}; }
        }
        __syncthreads();
#pragma unroll
        for (int i = 0; i < 4; ++i) { const int id = tid + 512 * i, j = id >> 6, l = id & 63;
            const u32x4 w = *(const LAS u32x4*)(Qd + ((16 * (j >> 3) + (l & 15)) * GP + 32 * (j & 7) + 8 * (l >> 4)) * 2);
            *(u32x4*)(Q + (size_t)(t0 + 2 * j + (l >> 5)) * 1024 + h * 256 + (l & 31) * 8) = w; }
        const int rt = wid >> 1, ct0 = (wid & 1) * 2;
        f32x4 o[2] = {{0, 0, 0, 0}, {0, 0, 0, 0}};
#pragma unroll
        for (int kk = 0; kk < 8; ++kk) {
            const bf16x8 af = *(const LAS bf16x8*)(Qd + ((16 * rt + fr) * GP + 32 * kk + 8 * fq) * 2);
#pragma unroll
            for (int c2 = 0; c2 < 2; ++c2) {
                const bf16x8 bfr = *(const LAS bf16x8*)(Ki + ((16 * (ct0 + c2) + fr) * GP + 32 * kk + 8 * fq) * 2);
                o[c2] = MFMA16(af, bfr, o[c2]);
            }
        }
#pragma unroll
        for (int c2 = 0; c2 < 2; ++c2)
#pragma unroll
            for (int j = 0; j < 4; ++j) {
                const int s = 16 * rt + 4 * fq + j, sp = 16 * (ct0 + c2) + fr;
                AIN[(size_t)unit * 4096 + (((rt * 2 + (sp >> 5)) * 64 + ((sp & 31) >> 3) * 16 + (s & 15)) << 3) + (sp & 7)] = f2bf(sp <= s ? o[c2][j] : 0.f);
            }
        __syncthreads();
    }
}
__device__ __forceinline__ void gla_seq(CArgs a, LAS unsigned char* lds) {
    const int blk = blockIdx.x; if (blk >= 128) return;
    unsigned char* ws = a->ws;
    const bf16_t* Q = (const bf16_t*)(ws + WS_Q); const bf16_t* Kk = (const bf16_t*)(ws + WS_K); const bf16_t* V = (const bf16_t*)(ws + WS_V);
    const bf16_t* AIN = (const bf16_t*)(ws + WS_AIN); const float* DEC = (const float*)(ws + WS_DEC); float* ORAW = (float*)(ws + WS_ORAW);
    const int bh = (blk & 7) + 8 * (blk >> 6), dvs = (blk >> 3) & 7, b = bh >> 2, h = bh & 3;
    const int tid = tid_local(), lane = tid & 63, wid = __builtin_amdgcn_readfirstlane(tid >> 6), fr = lane & 15, fq = lane >> 4, qq = fr >> 2, pp = lane & 3;
    constexpr int VB = 64 * VP * 2, SBB = 64 * GP * 2;
    LAS unsigned char* Vl = lds; LAS unsigned char* Sb = lds + 2 * VB;
    for (int e = tid; e < SBB / 16; e += 512) *(LAS u32x4*)(Sb + SBB + e * 16) = (u32x4){0, 0, 0, 0};
    f32x4 S[2][4];
#pragma unroll
    for (int r2 = 0; r2 < 2; ++r2)
#pragma unroll
        for (int ct = 0; ct < 4; ++ct) S[r2][ct] = (f32x4){0, 0, 0, 0};
    const int unit0 = bh * 128, vrow = tid >> 3, vch = tid & 7, rt = wid >> 1, ct0 = (wid & 1) * 2;
    const int dk0 = 16 * (2 * wid) + fr, dk1 = dk0 + 16;
    const size_t fragoff = (size_t)(lane >> 5) * 1024 + h * 256 + (lane & 31) * 8;
    const size_t voff = (size_t)vrow * 2048 + h * 512 + dvs * 64 + vch * 8;
    const int doff = 16 * (2 * wid) + 4 * fq;
    bf16x8 nq[8], na[2], nk[2][2]; f32x4 nd[2]; u32x4 nv;
#define GLA_LOAD(c) do { const size_t tb_ = (size_t)(b * SEQ + (c) * 64); const size_t ub_ = (size_t)(unit0 + (c)); \
        _Pragma("unroll") for (int kk = 0; kk < 8; ++kk) nq[kk] = *(const bf16x8*)(Q + (tb_ + 2 * (rt * 8 + kk)) * 1024 + fragoff); \
        _Pragma("unroll") for (int kk = 0; kk < 2; ++kk) { na[kk] = *(const bf16x8*)(AIN + ub_ * 4096 + ((rt * 2 + kk) * 64 + lane) * 8); \
            nk[0][kk] = *(const bf16x8*)(Kk + (tb_ + 2 * ((2 * wid) * 2 + kk)) * 1024 + fragoff); nk[1][kk] = *(const bf16x8*)(Kk + (tb_ + 2 * ((2 * wid + 1) * 2 + kk)) * 1024 + fragoff); } \
        nd[0] = *(const f32x4*)(DEC + ub_ * 256 + doff); nd[1] = *(const f32x4*)(DEC + ub_ * 256 + doff + 16); } while (0)
    nv = *(const u32x4*)(V + (size_t)(b * SEQ) * 2048 + voff);
    GLA_LOAD(0);
    *(LAS u32x4*)(Vl + (vrow * VP + vch * 8) * 2) = nv;
    __syncthreads();
    for (int c = 0; c < 128; ++c) {
        const int pb = c & 1;
        bf16x8 cq[8], ca[2], ck[2][2]; f32x4 cd[2];
#pragma unroll
        for (int kk = 0; kk < 8; ++kk) cq[kk] = nq[kk];
#pragma unroll
        for (int kk = 0; kk < 2; ++kk) { ca[kk] = na[kk]; ck[0][kk] = nk[0][kk]; ck[1][kk] = nk[1][kk]; }
        cd[0] = nd[0]; cd[1] = nd[1];
        if (c + 1 < 128) { nv = *(const u32x4*)(V + (size_t)(b * SEQ + (c + 1) * 64) * 2048 + voff); GLA_LOAD(c + 1); }
        const LAS unsigned char* Vc = Vl + pb * VB; const LAS unsigned char* Sp = Sb + (pb ^ 1) * SBB;
        {
            f32x4 o[2] = {{0, 0, 0, 0}, {0, 0, 0, 0}};
#pragma unroll
            for (int kk = 0; kk < 2; ++kk)
#pragma unroll
                for (int c2 = 0; c2 < 2; ++c2) {
                    const LAS unsigned char* vp = Vc + ((32 * kk + 8 * fq + qq) * VP + 16 * (ct0 + c2) + 4 * pp) * 2;
                    o[c2] = MFMA16(cat8(tr4(vp), tr4(vp + 4 * VP * 2)), ca[kk], o[c2]);
                }
#pragma unroll
            for (int kk = 0; kk < 8; ++kk)
#pragma unroll
                for (int c2 = 0; c2 < 2; ++c2) {
                    const bf16x8 bfr = *(const LAS bf16x8*)(Sp + ((16 * (ct0 + c2) + fr) * GP + 32 * kk + 8 * fq) * 2);
                    o[c2] = MFMA16(bfr, cq[kk], o[c2]);
                }
            const int t0 = b * SEQ + c * 64;
#pragma unroll
            for (int c2 = 0; c2 < 2; ++c2)
                *(f32x4*)(ORAW + (size_t)(t0 + 16 * rt + fr) * 2048 + h * 512 + dvs * 64 + 16 * (ct0 + c2) + 4 * fq) = o[c2];
        }
        {
#pragma unroll
            for (int r2 = 0; r2 < 2; ++r2)
#pragma unroll
                for (int ct = 0; ct < 4; ++ct) S[r2][ct] = S[r2][ct] * cd[r2];
#pragma unroll
            for (int kk = 0; kk < 2; ++kk)
#pragma unroll
                for (int ct = 0; ct < 4; ++ct) {
                    const LAS unsigned char* vp = Vc + ((32 * kk + 8 * fq + qq) * VP + 16 * ct + 4 * pp) * 2;
                    const bf16x8 bfr = cat8(tr4(vp), tr4(vp + 4 * VP * 2));
#pragma unroll
                    for (int r2 = 0; r2 < 2; ++r2) S[r2][ct] = MFMA16(ck[r2][kk], bfr, S[r2][ct]);
                }
        }
        LAS unsigned char* Sn = Sb + pb * SBB;
#pragma unroll
        for (int r2 = 0; r2 < 2; ++r2)
#pragma unroll
            for (int ct = 0; ct < 4; ++ct) {
                u32x2 w; w.x = pk2(S[r2][ct][0], S[r2][ct][1]); w.y = pk2(S[r2][ct][2], S[r2][ct][3]);
                *(LAS u32x2*)(Sn + ((16 * ct + fr) * GP + 16 * (2 * wid + r2) + 4 * fq) * 2) = w;
            }
        if (c + 1 < 128) *(LAS u32x4*)(Vl + (pb ^ 1) * VB + (vrow * VP + vch * 8) * 2) = nv;
        __syncthreads();
    }
#undef GLA_LOAD
}
__device__ __forceinline__ void gla_norm(CArgs a, int gw, int NGW, int lane) {
    unsigned char* ws = a->ws;
    const float* ORAW = (const float*)(ws + WS_ORAW); const bf16_t* R = (const bf16_t*)(ws + WS_R); bf16_t* OA = (bf16_t*)(ws + WS_OA);
    for (int m = gw; m < T; m += NGW) {
        const f32x4* orow = (const f32x4*)(ORAW + (size_t)m * 2048) + lane;
        const u32x2* rrow = (const u32x2*)(R + (size_t)m * 2048) + lane;
        u32x2* out = (u32x2*)(OA + (size_t)m * 2048) + lane;
        f32x4 v[8];
#pragma unroll
        for (int j = 0; j < 8; ++j) v[j] = __builtin_nontemporal_load(orow + 64 * j);
#pragma unroll
        for (int hh = 0; hh < 4; ++hh) {
            const f32x4 x0 = v[2 * hh], x1 = v[2 * hh + 1];
            float s = (x0[0] * x0[0] + x0[1] * x0[1]) + (x0[2] * x0[2] + x0[3] * x0[3]) + (x1[0] * x1[0] + x1[1] * x1[1]) + (x1[2] * x1[2] + x1[3] * x1[3]);
            const float rs = 1.0f / sqrtf(wave_sum(s) * (1.0f / 512.0f) + LN_EPS);
#pragma unroll
            for (int jj = 0; jj < 2; ++jj) {
                const int j = 2 * hh + jj;
                const f32x4 gg = ((const f32x4*)a->gla_g)[lane + 64 * j];
                const u32x2 rw = __builtin_nontemporal_load(rrow + 64 * j);
                const float r0 = bf_lo(rw.x), r1 = bf_hi(rw.x), r2 = bf_lo(rw.y), r3 = bf_hi(rw.y);
                const f32x4 x = v[j] * rs * gg;
                u32x2 w; w.x = pk2(x[0] * siluf_(r0), x[1] * siluf_(r1)); w.y = pk2(x[2] * siluf_(r2), x[3] * siluf_(r3));
                out[64 * j] = w;
            }
        }
    }
}
__device__ __forceinline__ void rope_tables(CArgs a) {
    float* cosT = (float*)(a->ws + WS_COS); float* sinT = (float*)(a->ws + WS_SIN);
    const size_t n = (size_t)T * 64;
    for (size_t e = (size_t)blockIdx.x * 512 + threadIdx.x; e < n; e += (size_t)gridDim.x * 512) {
        const int t = (int)(e >> 6), i = (int)(e & 63);
        const float fr = (float)exp2(-(double)i * (13.287712379549449 / 64.0));
        const float pos = (float)a->pos[t];
        const float ang = pos * fr;
        double rev = (double)ang * 0.15915494309189535; rev -= floor(rev);
        const float rv = (float)rev;
        cosT[e] = __builtin_amdgcn_cosf(rv); sinT[e] = __builtin_amdgcn_sinf(rv);
    }
}

constexpr int KP = 136;
__device__ __forceinline__ void dil_attn(CArgs a, LAS unsigned char* lds) {
    unsigned char* ws = a->ws;
    const bf16_t* DQ = (const bf16_t*)(ws + WS_DQ); const bf16_t* DK = (const bf16_t*)(ws + WS_DK); const bf16_t* DV = (const bf16_t*)(ws + WS_DV);
    bf16_t* OG = (bf16_t*)(ws + WS_OG); float* LSE = (float*)(ws + WS_LSE);
    const int tid = tid_local(), lane = tid & 63, wid = tid >> 6  , fr = lane & 15, fq = lane >> 4, qq = fr >> 2, pp = lane & 3;
    LAS unsigned char* Kt = lds; LAS unsigned char* Vt = lds + 256 * KP * 2;
    const int vcu = (gridDim.x & 7) == 0 ? (int)((blockIdx.x & 7) * (gridDim.x >> 3) + (blockIdx.x >> 3)) : (int)blockIdx.x;
    for (int unit = vcu; unit < 2 * 3 * 8 * 64; unit += gridDim.x) {
        const int u64 = unit & 63, hh = (unit >> 6) & 7, g = (unit >> 9) % 3, bl = unit / 1536;
        const int r = 1 << (2 * g), nb = 64 >> (2 * g), rc = u64 / nb, n = u64 % nb;
        const int tb = bl * SEQ, cb = g * 1024 + hh * 128;
        {
            const int ch = tid & 15, r0 = tid >> 4;
            const bool hasprev = n > 0;
            const size_t rowstep = (size_t)32 * r * 3072;
            const bf16_t* kp = DK + (size_t)(tb + (128 * (n - 1) + r0) * r + rc) * 3072 + cb + ch * 8;
            const bf16_t* vp = DV + (size_t)(tb + (128 * (n - 1) + r0) * r + rc) * 3072 + cb + ch * 8;
            u32x4 kr[8];
#pragma unroll
            for (int i = 0; i < 4; ++i) kr[i] = (u32x4){0, 0, 0, 0};
            if (hasprev) {
#pragma unroll
                for (int i = 0; i < 4; ++i) kr[i] = *(const u32x4*)(kp + i * rowstep);
            }
#pragma unroll
            for (int i = 4; i < 8; ++i) kr[i] = *(const u32x4*)(kp + i * rowstep);
#pragma unroll
            for (int i = 0; i < 8; ++i) *(LAS u32x4*)(Kt + ((r0 + 32 * i) * KP + ch * 8) * 2) = kr[i];
#pragma unroll
            for (int i = 0; i < 4; ++i) kr[i] = (u32x4){0, 0, 0, 0};
            if (hasprev) {
#pragma unroll
                for (int i = 0; i < 4; ++i) kr[i] = *(const u32x4*)(vp + i * rowstep);
            }
#pragma unroll
            for (int i = 4; i < 8; ++i) kr[i] = *(const u32x4*)(vp + i * rowstep);
#pragma unroll
            for (int i = 0; i < 8; ++i) *(LAS u32x4*)(Vt + ((r0 + 32 * i) * KP + ch * 8) * 2) = kr[i];
        }
        bf16x8 qf[4];
        { const size_t tq = (size_t)(tb + (128 * n + 16 * wid + fr) * r + rc);
#pragma unroll
          for (int kk = 0; kk < 4; ++kk) qf[kk] = *(const bf16x8*)(DQ + tq * 3072 + cb + 32 * kk + 8 * fq); }
        __syncthreads();
        f32x4 sc[10];
#pragma unroll
        for (int i = 0; i < 10; ++i) {
            const int kt = wid + i, ktc = kt < 15 ? kt : 15;
            f32x4 acc = {0, 0, 0, 0};
#pragma unroll
            for (int kk = 0; kk < 4; ++kk) {
                const bf16x8 af = *(const LAS bf16x8*)(Kt + ((16 * ktc + fr) * KP + 32 * kk + 8 * fq) * 2);
                acc = MFMA16(af, qf[kk], acc);
            }
            sc[i] = acc;
        }
        const int qi = 16 * wid + fr;
        const int klo = (n > 0 || qi >= 128) ? qi : 128, khi = qi + 128 < 255 ? qi + 128 : 255;
        float mx = -3.0e38f;
#pragma unroll
        for (int i = 0; i < 10; ++i)
#pragma unroll
            for (int j = 0; j < 4; ++j) {
                const int kj = 16 * (wid + i) + 4 * fq + j;
                const int dlo = kj - klo, dhi = khi - kj;
                const int dm = (dlo < dhi ? dlo : dhi) >> 31;
                sc[i][j] = fmaf((float)dm, 3.0e38f, sc[i][j]);
                mx = fmaxf(mx, sc[i][j]);
            }
        mx = fmaxf(mx, __shfl_xor(mx, 16)); mx = fmaxf(mx, __shfl_xor(mx, 32));
        float den = 0.f;
#pragma unroll
        for (int i = 0; i < 10; ++i)
#pragma unroll
            for (int j = 0; j < 4; ++j) { const float p = __expf(sc[i][j] - mx); sc[i][j] = p; den += p; }
        den += __shfl_xor(den, 16); den += __shfl_xor(den, 32);
        f32x4 o[8];
#pragma unroll
        for (int dt = 0; dt < 8; ++dt) o[dt] = (f32x4){0, 0, 0, 0};
#pragma unroll
        for (int pi = 0; pi < 5; ++pi) {
            const int kta = wid + 2 * pi, ktb = kta + 1, ka = kta < 15 ? kta : 15, kb = ktb < 15 ? ktb : 15;
            bf16x8 pf;
            { const unsigned w0 = pk2(sc[2 * pi][0], sc[2 * pi][1]), w1 = pk2(sc[2 * pi][2], sc[2 * pi][3]), w2 = pk2(sc[2 * pi + 1][0], sc[2 * pi + 1][1]), w3 = pk2(sc[2 * pi + 1][2], sc[2 * pi + 1][3]);
              pf = __builtin_bit_cast(bf16x8, (u32x4){w0, w1, w2, w3}); }
#pragma unroll
            for (int dt = 0; dt < 8; ++dt) {
                const LAS unsigned char* va = Vt + ((16 * ka + 4 * fq + qq) * KP + 16 * dt + 4 * pp) * 2;
                const LAS unsigned char* vb = Vt + ((16 * kb + 4 * fq + qq) * KP + 16 * dt + 4 * pp) * 2;
                const bf16x8 bfr = cat8(tr4(va), tr4(vb));
                o[dt] = MFMA16(pf, bfr, o[dt]);
            }
        }
        const float lse_l = mx + __logf(den);
        if (fq == 0) LSE[(size_t)(tb + (128 * n + qi) * r + rc) * 24 + g * 8 + hh] = lse_l;
#pragma unroll
        for (int j = 0; j < 4; ++j) {
            const float dj = __shfl(den, 4 * fq + j);
            const float inv = fast_rcp(dj);
            const size_t tq = (size_t)(tb + (128 * n + 16 * wid + 4 * fq + j) * r + rc);
#pragma unroll
            for (int dt = 0; dt < 8; ++dt) OG[tq * 3072 + cb + 16 * dt + fr] = f2bf(o[dt][j] * inv);
        }
        __syncthreads();
    }
}
__device__ __forceinline__ void dil_merge(CArgs a, int half, int gw, int NGW, int lane) {
    const bf16_t* OG = (const bf16_t*)(a->ws + WS_OG); const float* LSE = (const float*)(a->ws + WS_LSE); bf16_t* OB = (bf16_t*)(a->ws + WS_OB);
    const int hh = lane >> 3, d0 = (lane & 7) * 16;
    for (int m = gw; m < TH; m += NGW) {
        const float l0 = LSE[(size_t)m * 24 + hh], l1 = LSE[(size_t)m * 24 + 8 + hh], l2 = LSE[(size_t)m * 24 + 16 + hh];
        const float mx = fmaxf(l0, fmaxf(l1, l2));
        float w0 = __expf(l0 - mx), w1 = __expf(l1 - mx), w2 = __expf(l2 - mx);
        const float inv = 1.0f / (w0 + w1 + w2); w0 *= inv; w1 *= inv; w2 *= inv;
        const bf16_t* p = OG + (size_t)m * 3072 + hh * 128 + d0;
        bf16_t* o = OB + (size_t)(half * TH + m) * 1024 + hh * 128 + d0;
#pragma unroll
        for (int q = 0; q < 2; ++q) {
            const u32x4 a0 = *(const u32x4*)(p + 8 * q), a1 = *(const u32x4*)(p + 1024 + 8 * q), a2 = *(const u32x4*)(p + 2048 + 8 * q);
            u32x4 w;
            w.x = pk2(w0 * bf_lo(a0.x) + w1 * bf_lo(a1.x) + w2 * bf_lo(a2.x), w0 * bf_hi(a0.x) + w1 * bf_hi(a1.x) + w2 * bf_hi(a2.x));
            w.y = pk2(w0 * bf_lo(a0.y) + w1 * bf_lo(a1.y) + w2 * bf_lo(a2.y), w0 * bf_hi(a0.y) + w1 * bf_hi(a1.y) + w2 * bf_hi(a2.y));
            w.z = pk2(w0 * bf_lo(a0.z) + w1 * bf_lo(a1.z) + w2 * bf_lo(a2.z), w0 * bf_hi(a0.z) + w1 * bf_hi(a1.z) + w2 * bf_hi(a2.z));
            w.w = pk2(w0 * bf_lo(a0.w) + w1 * bf_lo(a1.w) + w2 * bf_lo(a2.w), w0 * bf_hi(a0.w) + w1 * bf_hi(a1.w) + w2 * bf_hi(a2.w));
            *(u32x4*)(o + 8 * q) = w;
        }
    }
}

constexpr size_t WS_BAR = 512 * 1024;
__device__ __forceinline__ void grid_barrier(unsigned* bar, unsigned& gen, unsigned G) {
    asm volatile("s_waitcnt vmcnt(0) lgkmcnt(0)" ::: "memory");
    __syncthreads();
    ++gen;
    if (threadIdx.x == 0) {
        __builtin_amdgcn_fence(__ATOMIC_RELEASE, "agent");
        asm volatile("s_waitcnt vmcnt(0)" ::: "memory");
        if ((G & 7u) == 0u) {
            const unsigned x = blockIdx.x & 7u, per = G >> 3;
            unsigned* cnt1 = bar + 64 * (1 + x); unsigned* cnt2 = bar + 64 * 9; unsigned* rel = bar + 64 * (10 + x);
            const unsigned old = __hip_atomic_fetch_add(cnt1, 1u, __ATOMIC_RELAXED, __HIP_MEMORY_SCOPE_AGENT);
            if (old + 1u == gen * per) {
                __hip_atomic_fetch_add(cnt2, 1u, __ATOMIC_RELAXED, __HIP_MEMORY_SCOPE_AGENT);
                while (__hip_atomic_load(cnt2, __ATOMIC_RELAXED, __HIP_MEMORY_SCOPE_AGENT) < gen * 8u) __builtin_amdgcn_s_sleep(1);
                __hip_atomic_fetch_add(rel, 1u, __ATOMIC_RELAXED, __HIP_MEMORY_SCOPE_AGENT);
            } else {
                while (__hip_atomic_load(rel, __ATOMIC_RELAXED, __HIP_MEMORY_SCOPE_AGENT) < gen) __builtin_amdgcn_s_sleep(1);
            }
        } else {
            __hip_atomic_fetch_add(bar, 1u, __ATOMIC_RELAXED, __HIP_MEMORY_SCOPE_AGENT);
            const unsigned target = gen * G;
            while (__hip_atomic_load(bar, __ATOMIC_RELAXED, __HIP_MEMORY_SCOPE_AGENT) < target) __builtin_amdgcn_s_sleep(2);
        }
        __builtin_amdgcn_fence(__ATOMIC_ACQUIRE, "agent");
        asm volatile("s_waitcnt vmcnt(0)" ::: "memory");
    }
    __syncthreads();
}

#ifndef PH_MASK
#define PH_MASK 0xffffffffu
#endif
#define ON(k) (((PH_MASK) >> (k)) & 1u)
#ifndef GEMM_SP2
#define GEMM_SP2 true
#endif
#ifndef GEMM_ALIGN
#define GEMM_ALIGN true
#endif
__global__ void __launch_bounds__(512, 2) fwd_megakernel(Args a_by_value) {
    extern __shared__ __attribute__((aligned(16))) unsigned char lds_raw[];
    LAS unsigned char* lds = (LAS unsigned char*)lds_raw;
    cg::grid_group grid = cg::this_grid();
    const int tid = tid_local(), lane = tid & 63, wave = __builtin_amdgcn_readfirstlane(tid >> 6);
    const int G = gridDim.x, gw = blockIdx.x * 8 + wave, NGW = G * 8;
    const CArgs ap0 = (CArgs)__builtin_amdgcn_kernarg_segment_ptr();
    LAS float* scr = (LAS float*)(lds + wave * 16384);
#define PH_BEGIN const CArgs a = launder(ap0); unsigned char* const ws = a->ws; float* const mods = (float*)(ws + WS_MODS); (void)mods;
#define Wgu ((bf16_t*)(ws + WS_WGU))
#define Wd ((bf16_t*)(ws + WS_WD))
#define Win ((bf16_t*)(ws + WS_WIN))
#define Wa ((bf16_t*)(ws + WS_WA))
#define Wb ((bf16_t*)(ws + WS_WB))
#define Wo ((bf16_t*)(ws + WS_WO))
#define H ((bf16_t*)(ws + WS_H))
#define ACT ((bf16_t*)(ws + WS_ACT))
    using pg8::Gemm; using pg8::StaticOrder;
    unsigned bar_gen = 0;
    {
        unsigned char* w0 = launder(ap0)->ws;
        const int gid = (int)blockIdx.x * 512 + tid;
        if (gid < (NB * NMOD * D) / 4) ((u32x4*)(w0 + WS_MODS))[gid] = (u32x4){0, 0, 0, 0};
        if (blockIdx.x == 0) for (int i = tid; i < 64 * 20; i += 512) ((unsigned*)(w0 + WS_BAR))[i] = 0u;
        asm volatile("s_waitcnt vmcnt(0)" ::: "memory");
    }
    grid.sync();
#define GRID_SYNC() grid_barrier((unsigned*)(launder(ap0)->ws + WS_BAR), bar_gen, (unsigned)G)

    { PH_BEGIN
    if (ON(0)) for (int it = gw; it < 72 * 16; it += NGW) mods_item(a, mods, scr, it, lane);
    if (ON(0)) {
        constexpr int total = (D / 64) * (2 * FF / 32);
        for (int it = gw; it < total; it += NGW) { int r = it; tj(a->w_gu1, D, 2 * FF, Wgu, 0, 2 * FF, 0, 2, r, scr, lane); }
    }
    }
    GRID_SYNC();
    { PH_BEGIN
    if (ON(1)) modulate_rows(a->x, mods, 0, H, gw, NGW, lane);
    if (ON(1)) {
        constexpr int total = (FF / 64) * (D / 32) + (D / 64) * ((6144 + 32) / 32);
        for (int it = gw; it < total; it += NGW) {
            int r = it;
            if (tj(a->w_d1, FF, D, Wd, 0, D, 0, 0, r, scr, lane)) continue;
            tj(a->w_in, D, WIN_SRC, Win, WR_GLA, 6144 + 32, 0, 0, r, scr, lane);
        }
    }
    }
    GRID_SYNC();
    { PH_BEGIN
    if (ON(2)) { Gemm g{H, Wgu, T, 2 * FF, D}; StaticOrder S; S.init(T, 2 * FF, G, (int)blockIdx.x); EpiGU E{ACT};
      pg8::gemm_phase<EpiGU, StaticOrder, GEMM_ALIGN, GEMM_SP2>(lds, g, S, E); }
    }
    GRID_SYNC();
    { PH_BEGIN
    if (ON(3)) { Gemm g{ACT, Wd, T, D, FF}; StaticOrder S; S.init(T, D, G, (int)blockIdx.x); EpiRes E{a->x, a->out, mods + 2 * D, 0.5f};
      pg8::gemm_phase<EpiRes, StaticOrder, GEMM_ALIGN, GEMM_SP2>(lds, g, S, E); }
    }
    GRID_SYNC();
    { PH_BEGIN
    if (ON(4)) ln_rows(a->out, a->ln1_g, a->ln1_b, mods, 3, H, gw, NGW, lane);
    }
    GRID_SYNC();
    { PH_BEGIN
    if (ON(5)) { Gemm g{H, Win + (size_t)WR_GLA * D, T, 25 * 256, D}; StaticOrder S; S.init(T, 25 * 256, G, (int)blockIdx.x);
      EpiGla E{(bf16_t*)(ws + WS_Q), (bf16_t*)(ws + WS_K), (bf16_t*)(ws + WS_V), (bf16_t*)(ws + WS_R), (float*)(ws + WS_GLR)};
      pg8::gemm_phase<EpiGla, StaticOrder, GEMM_ALIGN, GEMM_SP2>(lds, g, S, E); }
    }
    GRID_SYNC();
    { PH_BEGIN
    if (ON(6)) gla_prep(a, lds);
    }
    GRID_SYNC();
    { PH_BEGIN
    if (ON(7)) {
        if (blockIdx.x < 128) gla_seq(a, lds);
        else {
            const int gw2 = (blockIdx.x - 128) * 8 + wave, NGW2 = (G - 128) * 8;
            constexpr int total = (D / 64) * ((3072 + 3072 + 7168) / 32) + (2048 / 64) * (D / 32) + (1024 / 64) * (D / 32) + (D / 64) * (D / 32) + (D / 64) * (2 * FF / 32) + (FF / 64) * (D / 32);
            for (int it = gw2; it < total; it += NGW2) {
                int r = it;
                if (tj(a->w_in, D, WIN_SRC, Win, WR_DQ, 3072, 6160, 1, r, scr, lane)) continue;
                if (tj(a->w_in, D, WIN_SRC, Win, WR_DK, 3072, 9232, 1, r, scr, lane)) continue;
                if (tj(a->w_in, D, WIN_SRC, Win, WR_DV, 3072 + 4096, 12304, 0, r, scr, lane)) continue;
                if (tj(a->w_a, 2048, D, Wa, 0, D, 0, 0, r, scr, lane)) continue;
                if (tj(a->w_b, 1024, D, Wb, 0, D, 0, 0, r, scr, lane)) continue;
                if (tj(a->w_o, D, D, Wo, 0, D, 0, 0, r, scr, lane)) continue;
                if (tj(a->w_gu2, D, 2 * FF, Wgu, 0, 2 * FF, 0, 2, r, scr, lane)) continue;
                tj(a->w_d2, FF, D, Wd, 0, D, 0, 0, r, scr, lane);
            }
        }
    }
    }
    GRID_SYNC();
    { PH_BEGIN
    if (ON(8)) gla_norm(a, gw, NGW, lane);
    if (ON(9)) rope_tables(a);
    }
    GRID_SYNC();
    for (int half = 0; half < 2; ++half) {
        { PH_BEGIN
        if (ON(11) && half == 1) dil_merge(a, 0, gw, NGW, lane);
        if (ON(9)) { Gemm g{H + (size_t)half * TH * D, Win + (size_t)WR_DQ * D, TH, 36 * 256, D}; StaticOrder S; S.init(TH, 36 * 256, G, (int)blockIdx.x);
          EpiDil E{(bf16_t*)(ws + WS_DQ), (bf16_t*)(ws + WS_DK), (bf16_t*)(ws + WS_DV), (const float*)(ws + WS_COS) + (size_t)half * TH * 64, (const float*)(ws + WS_SIN) + (size_t)half * TH * 64};
          pg8::gemm_phase<EpiDil, StaticOrder, GEMM_ALIGN, GEMM_SP2>(lds, g, S, E); }
        }
        GRID_SYNC();
        { PH_BEGIN
        if (ON(10)) dil_attn(a, lds);
        }
        GRID_SYNC();
    }
    { PH_BEGIN
    if (ON(11)) dil_merge(a, 1, gw, NGW, lane);
    if (ON(13)) { Gemm g{H, Win + (size_t)WR_GATE * D, T, 16 * 256, D}; StaticOrder S; S.init(T, 16 * 256, G, (int)blockIdx.x);
      EpiGates E{(bf16_t*)(ws + WS_SGA), (bf16_t*)(ws + WS_SGB)};
      pg8::gemm_phase<EpiGates, StaticOrder, GEMM_ALIGN, GEMM_SP2>(lds, g, S, E); }
    }
    GRID_SYNC();
    { PH_BEGIN
    if (ON(14)) { Gemm g{(const bf16_t*)(ws + WS_OA), Wa, T, D, 2048}; StaticOrder S; S.init(T, D, G, (int)blockIdx.x);
      EpiMul<false> E{(const bf16_t*)(ws + WS_SGA), (bf16_t*)(ws + WS_SGA)};
      pg8::gemm_phase<EpiMul<false>, StaticOrder, GEMM_ALIGN, GEMM_SP2>(lds, g, S, E); }
    }
    { PH_BEGIN
    if (ON(15)) { Gemm g{(const bf16_t*)(ws + WS_OB), Wb, T, D, 1024}; StaticOrder S; S.init(T, D, G, (int)blockIdx.x);
      EpiMul<true> E{(const bf16_t*)(ws + WS_SGB), (bf16_t*)(ws + WS_SGA)};
      pg8::gemm_phase<EpiMul<true>, StaticOrder, GEMM_ALIGN, GEMM_SP2>(lds, g, S, E); }
    }
    GRID_SYNC();
    { PH_BEGIN
    if (ON(16)) { Gemm g{(const bf16_t*)(ws + WS_SGA), Wo, T, D, D}; StaticOrder S; S.init(T, D, G, (int)blockIdx.x); EpiRes E{a->out, a->out, mods + 5 * D, 1.0f};
      pg8::gemm_phase<EpiRes, StaticOrder, GEMM_ALIGN, GEMM_SP2>(lds, g, S, E); }
    }
    GRID_SYNC();
    { PH_BEGIN
    if (ON(17)) ln_rows(a->out, a->ln2_g, a->ln2_b, mods, 6, H, gw, NGW, lane);
    }
    GRID_SYNC();
    { PH_BEGIN
    if (ON(18)) { Gemm g{H, Wgu, T, 2 * FF, D}; StaticOrder S; S.init(T, 2 * FF, G, (int)blockIdx.x); EpiGU E{ACT};
      pg8::gemm_phase<EpiGU, StaticOrder, GEMM_ALIGN, GEMM_SP2>(lds, g, S, E); }
    }
    GRID_SYNC();
    { PH_BEGIN
    if (ON(19)) { Gemm g{ACT, Wd, T, D, FF}; StaticOrder S; S.init(T, D, G, (int)blockIdx.x); EpiRes E{a->out, a->out, mods + 8 * D, 0.5f};
      pg8::gemm_phase<EpiRes, StaticOrder, GEMM_ALIGN, GEMM_SP2>(lds, g, S, E); }
    }
    GRID_SYNC();
    { PH_BEGIN
    if (ON(20)) ln_rows(a->out, a->ln3_g, a->ln3_b, mods, 0, nullptr, gw, NGW, lane);
    }
}

extern "C" void kernel_launch(void* const* d_in, const int* in_sizes, int n_in, void* d_out, int out_size, void* d_ws, size_t ws_size, hipStream_t stream) {
    static int grid = 0;
    if (grid == 0) {
        if (n_in != 22 || out_size != T * D || ws_size < WS_END) { fprintf(stderr, "kernel_launch: unexpected shapes: n_in %d out %d ws %zu\n", n_in, out_size, ws_size); grid = -1; return; }
        int dev = 0, cus = 0, per_cu = 0;
        hipGetDevice(&dev); hipDeviceGetAttribute(&cus, hipDeviceAttributeMultiprocessorCount, dev);
        hipFuncSetAttribute((const void*)fwd_megakernel, hipFuncAttributeMaxDynamicSharedMemorySize, LDS_BYTES);
        hipOccupancyMaxActiveBlocksPerMultiprocessor(&per_cu, (const void*)fwd_megakernel, 512, LDS_BYTES);
        (void)hipGetLastError();
        if (per_cu < 1) fprintf(stderr, "kernel_launch: occupancy query says %d blocks/CU\n", per_cu);
        grid = cus;
    }
    if (grid < 0) return;
    Args a{};
    a.x = (const float*)d_in[0]; a.c = (const float*)d_in[1]; a.pos = (const int*)d_in[2]; a.w_ada = (const float*)d_in[3]; a.b_ada = (const float*)d_in[4];
    a.ln1_g = (const float*)d_in[5]; a.ln1_b = (const float*)d_in[6]; a.w_gu1 = (const float*)d_in[7]; a.w_d1 = (const float*)d_in[8];
    a.w_in = (const float*)d_in[9]; a.w_alpha2 = (const float*)d_in[10]; a.b_alpha = (const float*)d_in[11]; a.gla_g = (const float*)d_in[12];
    a.w_a = (const float*)d_in[13]; a.w_b = (const float*)d_in[14]; a.w_o = (const float*)d_in[15]; a.ln2_g = (const float*)d_in[16]; a.ln2_b = (const float*)d_in[17];
    a.w_gu2 = (const float*)d_in[18]; a.w_d2 = (const float*)d_in[19]; a.ln3_g = (const float*)d_in[20]; a.ln3_b = (const float*)d_in[21];
    a.out = (float*)d_out; a.ws = (unsigned char*)d_ws;
    void* args[] = {&a};
    hipError_t e = hipLaunchCooperativeKernel((const void*)fwd_megakernel, dim3(grid), dim3(512), args, LDS_BYTES, stream);
    if (e != hipSuccess) fprintf(stderr, "kernel_launch: cooperative launch failed: %s (grid %d)\n", hipGetErrorString(e), grid);
}
```

```cpp
#include <hip/hip_runtime.h>
#include <hip/hip_cooperative_groups.h>
#include <cstdio>
#include <cstdint>
namespace cg = cooperative_groups;

#define LAS __attribute__((address_space(3)))
typedef unsigned short bf16_t;
typedef short bf16x8 __attribute__((ext_vector_type(8)));
typedef short s16x4 __attribute__((ext_vector_type(4)));
typedef float f32x4 __attribute__((ext_vector_type(4)));
typedef float f32x2 __attribute__((ext_vector_type(2)));
typedef unsigned u32x4 __attribute__((ext_vector_type(4)));
typedef unsigned u32x2 __attribute__((ext_vector_type(2)));

__device__ __forceinline__ int tid_local() { int t = threadIdx.x; asm volatile("" : "+v"(t)); return t; }

namespace pg8 {
constexpr int BM = 256, BK = 64, HALF = 128, HTB = HALF * BK * 2, STAGE_BYTES = 8 * HTB, NXCD = 8, WGM = 8;
__host__ __device__ __forceinline__ int lds_byte(int r, int c) { const int st = (r >> 4) * 2 + (c >> 5), rr = r & 15, cc = c & 31, ob = rr * 64 + cc * 2; return st * 1024 + (ob ^ (((ob >> 9) & 1) << 5)); }
__host__ __device__ __forceinline__ void stage_rc(int b, int& R, int& C) { const int st = b / 1024, sb = b % 1024, swz = sb ^ (((sb >> 9) & 1) << 5); R = (st >> 1) * 16 + swz / 64; C = (st & 1) * 32 + (swz % 64) / 2; }
__host__ __device__ __forceinline__ int perm32(int rho) { const int n = rho >> 4, i = rho & 15; return 8 * (i >> 2) + 4 * n + (i & 3); }
struct Unit { int pm, pn; };
struct Gemm { const bf16_t* A; const bf16_t* Bt; int M, N, K; };
struct StaticOrder {
    int nM, nN, nwg, G, c;
    __device__ void init(int M, int N, int G_, int c_) { nM = M / BM; nN = N / BM; nwg = nM * nN; G = G_; c = c_; }
    __device__ bool next(int i, Unit& u) const {
        const long L = (long)i * G + c; if (L >= nwg) return false;
        int wgid = (int)L; { const int q = nwg / NXCD, r = nwg % NXCD, xcd = wgid % NXCD, off = wgid / NXCD; wgid = (xcd < r ? xcd * (q + 1) : r * (q + 1) + (xcd - r) * q) + off; }
        const int nig = WGM * nN, gid = wgid / nig, fm = gid * WGM, gsz = (nM - fm) < WGM ? (nM - fm) : WGM;
        u.pm = fm + ((wgid % nig) % gsz); u.pn = (wgid % nig) / gsz; return true;
    }
    __device__ __forceinline__ void a_ready(const Unit&) const {}
    __device__ __forceinline__ void done(const Unit&) const {}
};
typedef float f32x2_t __attribute__((ext_vector_type(2)));
typedef __bf16 bf16x2_t __attribute__((ext_vector_type(2)));
__device__ __forceinline__ unsigned cvt_pk_bf16(float lo, float hi) { f32x2_t v = {lo, hi}; bf16x2_t b = __builtin_convertvector(v, bf16x2_t); return __builtin_bit_cast(unsigned, b); }

template <class Epi, class Sched, bool ALIGN_EPI = false, bool SP2 = false>
__device__ __forceinline__ void gemm_phase(LAS unsigned char* lds, const Gemm g, const Sched& S, const Epi& E) {
    const int tid = tid_local(), wid = __builtin_amdgcn_readfirstlane(tid >> 6), lane = tid & 63, wr = wid >> 2, wc = wid & 3, fr = lane & 15, fq = lane >> 4;
    const int K = g.K, nt = K / BK;
    unsigned voffA[2], voffB[2];
#pragma unroll
    for (int i = 0; i < 2; ++i) { int R, C; stage_rc(tid * 16 + i * 8192, R, C); const int Rb = Epi::PERM ? ((R & ~31) + perm32(R & 31)) : R;
        voffA[i] = (unsigned)(R * K + C) * 2u; voffB[i] = (unsigned)(Rb * K + C) * 2u; }
    const size_t kstep = (size_t)(BK * 2);
    const size_t hstep = (size_t)HALF * K * 2;
    const size_t tstep = 2 * hstep;
    const unsigned ldsw = (unsigned)wid * 1024u;
    const int aoff = lds_byte(wr * 64 + fr, fq * 8), boff = lds_byte(wc * 32 + fr, fq * 8);
#define PG8_SA(b, h) (((b) * 2 + (h)) * HTB)
#define PG8_SB(b, h) ((4 + (b) * 2 + (h)) * HTB)
#define PG8_STAGE(bufoff, gbase, voff) do { _Pragma("unroll") for (int _i = 0; _i < 2; ++_i) \
        __builtin_amdgcn_global_load_lds((const unsigned*)((const char*)(gbase) + (voff)[_i]), (LAS unsigned*)(lds + (bufoff) + ldsw + _i * 8192), 16, 0, 1); } while (0)
#define PG8_LDA(dst, b, h) do { _Pragma("unroll") for (int m = 0; m < 4; ++m) _Pragma("unroll") for (int k = 0; k < 2; ++k) dst[m][k] = *(const LAS bf16x8*)(lds + PG8_SA(b, h) + aoff + m * 2048 + k * 1024); } while (0)
#define PG8_LDB(dst, b, h) do { _Pragma("unroll") for (int n = 0; n < 2; ++n) _Pragma("unroll") for (int k = 0; k < 2; ++k) dst[n][k] = *(const LAS bf16x8*)(lds + PG8_SB(b, h) + boff + n * 2048 + k * 1024); } while (0)
#define PG8_MMA(ai, bj, At, Bt) do { __builtin_amdgcn_s_setprio(1); _Pragma("unroll") for (int m = 0; m < 4; ++m) _Pragma("unroll") for (int n = 0; n < 2; ++n) _Pragma("unroll") for (int k = 0; k < 2; ++k) \
        acc[ai][bj][m][n] = __builtin_amdgcn_mfma_f32_16x16x32_bf16(Bt[n][k], At[m][k], acc[ai][bj][m][n], 0, 0, 0); __builtin_amdgcn_s_setprio(0); } while (0)
#define PG8_WAIT_V(n) asm volatile("s_waitcnt vmcnt(" #n ")" ::: "memory")
#define PG8_WAIT_L(n) asm volatile("s_waitcnt lgkmcnt(" #n ")" ::: "memory")
#define PG8_BAR __builtin_amdgcn_s_barrier()
#define PG8_SCHED __builtin_amdgcn_sched_barrier(0)
    Unit cur, nxt; int ui = 0;
    if (!S.next(0, cur)) return;
    f32x4 acc[2][2][4][2];
#pragma unroll
    for (int a = 0; a < 2; ++a)
#pragma unroll
        for (int b = 0; b < 2; ++b)
#pragma unroll
            for (int m = 0; m < 4; ++m)
#pragma unroll
                for (int n = 0; n < 2; ++n) acc[a][b][m][n] = (f32x4){0.f, 0.f, 0.f, 0.f};
    bf16x8 At[4][2], B0[2][2], B1[2][2];
    const char* cA = (const char*)g.A + (size_t)cur.pm * tstep; const char* cB = (const char*)g.Bt + (size_t)cur.pn * tstep;
    S.a_ready(cur);
    if constexpr (SP2) {
        PG8_STAGE(PG8_SB(0, 0), cB, voffB); PG8_STAGE(PG8_SB(0, 1), cB + hstep, voffB); PG8_STAGE(PG8_SA(0, 0), cA, voffA); PG8_STAGE(PG8_SA(0, 1), cA + hstep, voffA);
        if (wr == 1) PG8_BAR;
        PG8_WAIT_V(2); PG8_BAR;
        PG8_STAGE(PG8_SB(1, 0), cB + kstep, voffB); PG8_STAGE(PG8_SA(1, 0), cA + kstep, voffA); PG8_STAGE(PG8_SB(1, 1), cB + hstep + kstep, voffB);
        PG8_WAIT_V(6); PG8_BAR;
    } else {
        PG8_STAGE(PG8_SB(0, 0), cB, voffB); PG8_STAGE(PG8_SA(0, 0), cA, voffA); PG8_STAGE(PG8_SB(0, 1), cB + hstep, voffB); PG8_STAGE(PG8_SA(0, 1), cA + hstep, voffA);
        if (wr == 1) PG8_BAR;
        PG8_WAIT_V(4); PG8_BAR;
        PG8_STAGE(PG8_SB(1, 0), cB + kstep, voffB); PG8_STAGE(PG8_SA(1, 0), cA + kstep, voffA); PG8_STAGE(PG8_SB(1, 1), cB + hstep + kstep, voffB);
        PG8_WAIT_V(6); PG8_BAR;
    }
    for (;;) {
        const bool has_next = S.next(ui + 1, nxt);
        const char* nA = has_next ? (const char*)g.A + (size_t)nxt.pm * tstep : cA; const char* nB = has_next ? (const char*)g.Bt + (size_t)nxt.pn * tstep : cB;
        for (int t = 0; t < nt; t += 2) {
            const bool last = (t == nt - 2);
            const char* a1 = cA + (size_t)(t + 1) * kstep;
            const char* a2 = last ? nA : cA + (size_t)(t + 2) * kstep; const char* b2 = last ? nB : cB + (size_t)(t + 2) * kstep;
            const char* a3 = a2 + kstep; const char* b3 = b2 + kstep;
            if (last && has_next) S.a_ready(nxt);
            if constexpr (SP2) {
            PG8_LDB(B0, 0, 0); PG8_LDB(B1, 0, 1); PG8_SCHED; PG8_LDA(At, 0, 0); PG8_STAGE(PG8_SA(1, 1), a1 + hstep, voffA);
            PG8_WAIT_V(8); PG8_WAIT_L(0); PG8_BAR; PG8_MMA(0, 0, At, B0); PG8_MMA(0, 1, At, B1); PG8_BAR; PG8_SCHED;
            PG8_LDA(At, 0, 1); PG8_STAGE(PG8_SB(0, 0), b2, voffB); PG8_STAGE(PG8_SB(0, 1), b2 + hstep, voffB); PG8_STAGE(PG8_SA(0, 0), a2, voffA);
            PG8_WAIT_V(8); PG8_WAIT_L(0); PG8_BAR; PG8_MMA(1, 0, At, B0); PG8_MMA(1, 1, At, B1); PG8_BAR; PG8_SCHED;
            PG8_LDB(B0, 1, 0); PG8_LDB(B1, 1, 1); PG8_SCHED; PG8_LDA(At, 1, 0); PG8_STAGE(PG8_SA(0, 1), a2 + hstep, voffA);
            PG8_WAIT_V(8); PG8_WAIT_L(0); PG8_BAR; PG8_MMA(0, 0, At, B0); PG8_MMA(0, 1, At, B1); PG8_BAR; PG8_SCHED;
            PG8_LDA(At, 1, 1); PG8_STAGE(PG8_SB(1, 0), b3, voffB); PG8_STAGE(PG8_SB(1, 1), b3 + hstep, voffB); PG8_STAGE(PG8_SA(1, 0), a3, voffA);
            PG8_WAIT_V(8); PG8_WAIT_L(0); PG8_BAR; PG8_MMA(1, 0, At, B0); PG8_MMA(1, 1, At, B1); PG8_BAR; PG8_SCHED;
            } else {
            PG8_LDB(B0, 0, 0); PG8_SCHED; PG8_LDA(At, 0, 0); PG8_STAGE(PG8_SA(1, 1), a1 + hstep, voffA);
            PG8_WAIT_L(8); PG8_BAR; PG8_WAIT_L(0); PG8_MMA(0, 0, At, B0); PG8_BAR; PG8_SCHED;
            PG8_LDB(B1, 0, 1); PG8_STAGE(PG8_SB(0, 0), b2, voffB);
            PG8_BAR; PG8_WAIT_L(0); PG8_MMA(0, 1, At, B1); PG8_BAR;
            PG8_LDA(At, 0, 1); PG8_STAGE(PG8_SA(0, 0), a2, voffA);
            PG8_BAR; PG8_WAIT_L(0); PG8_MMA(1, 0, At, B0); PG8_BAR; PG8_SCHED;
            PG8_STAGE(PG8_SB(0, 1), b2 + hstep, voffB);
            PG8_WAIT_V(6); PG8_BAR; PG8_MMA(1, 1, At, B1); PG8_BAR;
            PG8_LDB(B0, 1, 0); PG8_SCHED; PG8_LDA(At, 1, 0); PG8_STAGE(PG8_SA(0, 1), a2 + hstep, voffA);
            PG8_WAIT_L(8); PG8_BAR; PG8_WAIT_L(0); PG8_MMA(0, 0, At, B0); PG8_BAR; PG8_SCHED;
            PG8_LDB(B1, 1, 1); PG8_STAGE(PG8_SB(1, 0), b3, voffB);
            PG8_BAR; PG8_WAIT_L(0); PG8_MMA(0, 1, At, B1); PG8_BAR;
            PG8_LDA(At, 1, 1); PG8_STAGE(PG8_SA(1, 0), a3, voffA);
            PG8_BAR; PG8_WAIT_L(0); PG8_MMA(1, 0, At, B0); PG8_BAR; PG8_SCHED;
            PG8_STAGE(PG8_SB(1, 1), b3 + hstep, voffB);
            PG8_WAIT_V(6); PG8_BAR; PG8_MMA(1, 1, At, B1); PG8_BAR;
            }
        }
        if constexpr (ALIGN_EPI) { if (wr == 0) PG8_BAR; }
        E(acc, cur, wr, wc, fr, fq);
        if (!has_next) break;
#pragma unroll
        for (int a = 0; a < 2; ++a)
#pragma unroll
            for (int b = 0; b < 2; ++b)
#pragma unroll
                for (int m = 0; m < 4; ++m)
#pragma unroll
                    for (int n = 0; n < 2; ++n) acc[a][b][m][n] = (f32x4){0.f, 0.f, 0.f, 0.f};
        cur = nxt; cA = nA; cB = nB; ++ui;
        if constexpr (ALIGN_EPI) { if (wr == 1) PG8_BAR; }
    }
    PG8_WAIT_V(0);
    if constexpr (!ALIGN_EPI) { if (wr == 0) PG8_BAR; }
    PG8_BAR;
#undef PG8_SA
#undef PG8_SB
#undef PG8_STAGE
#undef PG8_LDA
#undef PG8_LDB
#undef PG8_MMA
#undef PG8_WAIT_V
#undef PG8_WAIT_L
#undef PG8_BAR
#undef PG8_SCHED
}
}

constexpr int NB = 4, SEQ = 8192, T = NB * SEQ, D = 2048, FF = 5632, NMOD = 9;
constexpr int TH = T / 2;
constexpr float LN_EPS = 1e-5f;
constexpr float DN_ALPHA = 1.189207115002721f;
constexpr int WIN_SRC = 19472;
constexpr int WIN_ROWS = 77 * 256;
constexpr int WR_GLA = 0, WR_GLR = 6144, WR_DQ = 6400, WR_DK = 9472, WR_DV = 12544, WR_GATE = 15616;

constexpr size_t MiB = 1u << 20;
constexpr size_t WS_MODS = 0;
constexpr size_t CTL_ZERO_BYTES = 1 * MiB;
constexpr size_t WS_GLR = 1 * MiB;
constexpr size_t WS_AIN = 3 * MiB;
constexpr size_t WS_COS = 3 * MiB, WS_SIN = 11 * MiB;
constexpr size_t WS_DEC = 19 * MiB;
constexpr size_t WS_LSE = 21 * MiB;
constexpr size_t WS_WGU = 23 * MiB;
constexpr size_t WS_WD = 67 * MiB;
constexpr size_t WS_WIN = 89 * MiB;
constexpr size_t WS_WA = 166 * MiB, WS_WB = 174 * MiB, WS_WO = 178 * MiB;
constexpr size_t WS_H = 186 * MiB;
constexpr size_t WS_ACT = 314 * MiB;
constexpr size_t WS_Q = 314 * MiB, WS_K = 378 * MiB, WS_V = 442 * MiB, WS_R = 570 * MiB, WS_ORAW = 698 * MiB;
constexpr size_t WS_OA = 314 * MiB;
constexpr size_t WS_DQ = 442 * MiB, WS_DK = 538 * MiB, WS_DV = 634 * MiB;
constexpr size_t WS_OB = 730 * MiB;
constexpr size_t WS_OG = 794 * MiB;
constexpr size_t WS_SGA = 442 * MiB, WS_SGB = 570 * MiB;
constexpr size_t WS_END = 954 * MiB;

constexpr int LDS_BYTES = 147456;

struct Args {
    const float* x; const float* c; const int* pos; const float* w_ada; const float* b_ada;
    const float* ln1_g; const float* ln1_b; const float* w_gu1; const float* w_d1;
    const float* w_in; const float* w_alpha2; const float* b_alpha; const float* gla_g;
    const float* w_a; const float* w_b; const float* w_o; const float* ln2_g; const float* ln2_b;
    const float* w_gu2; const float* w_d2; const float* ln3_g; const float* ln3_b;
    float* out; unsigned char* ws;
};

typedef const Args __attribute__((address_space(4)))* CArgs;
__device__ __forceinline__ CArgs launder(CArgs p) { asm volatile("" : "+s"(p)); return p; }

__device__ __forceinline__ unsigned pk2(float lo, float hi) { return pg8::cvt_pk_bf16(lo, hi); }
__device__ __forceinline__ float bf_lo(unsigned w) { return __uint_as_float(w << 16); }
__device__ __forceinline__ float bf_hi(unsigned w) { return __uint_as_float(w & 0xffff0000u); }
__device__ __forceinline__ float bf2f(bf16_t h) { return __uint_as_float(((unsigned)h) << 16); }
__device__ __forceinline__ bf16_t f2bf(float f) { unsigned u = __float_as_uint(f); return (bf16_t)((u + 0x7fffu + ((u >> 16) & 1u)) >> 16); }
__device__ __forceinline__ float fast_rcp(float x) { return __builtin_amdgcn_rcpf(x); }
__device__ __forceinline__ float sigmoidf_(float x) { return fast_rcp(1.0f + __expf(-x)); }
__device__ __forceinline__ float siluf_(float x) { return x * sigmoidf_(x); }
__device__ __forceinline__ float wave_sum(float v) {
#pragma unroll
    for (int o = 1; o < 64; o <<= 1) v += __shfl_xor(v, o);
    return v;
}
__device__ __forceinline__ s16x4 tr4(const LAS unsigned char* p) { return __builtin_bit_cast(s16x4, __builtin_amdgcn_ds_read_tr16_b64_v4i16((LAS s16x4*)p)); }
__device__ __forceinline__ bf16x8 cat8(s16x4 a, s16x4 b) { return (bf16x8){a[0], a[1], a[2], a[3], b[0], b[1], b[2], b[3]}; }
#define MFMA16(a, b, c) __builtin_amdgcn_mfma_f32_16x16x32_bf16((a), (b), (c), 0, 0, 0)

struct EpiGU {
    static constexpr bool PERM = true;
    bf16_t* O;
    __device__ __forceinline__ void operator()(const f32x4 (&acc)[2][2][4][2], const pg8::Unit& u, int wr, int wc, int fr, int fq) const {
        const int row0 = u.pm * 256 + wr * 64 + fr, col0 = u.pn * 128 + wc * 32 + 8 * fq;
#pragma unroll
        for (int ai = 0; ai < 2; ++ai)
#pragma unroll
            for (int m = 0; m < 4; ++m) {
                const f32x4 g0 = acc[ai][0][m][0], g1 = acc[ai][0][m][1], u0 = acc[ai][1][m][0], u1 = acc[ai][1][m][1];
                u32x4 w;
                w.x = pk2(siluf_(g0[0]) * u0[0], siluf_(g0[1]) * u0[1]); w.y = pk2(siluf_(g0[2]) * u0[2], siluf_(g0[3]) * u0[3]);
                w.z = pk2(siluf_(g1[0]) * u1[0], siluf_(g1[1]) * u1[1]); w.w = pk2(siluf_(g1[2]) * u1[2], siluf_(g1[3]) * u1[3]);
                *(u32x4*)(O + (size_t)(row0 + ai * 128 + m * 16) * FF + col0) = w;
            }
    }
};
struct EpiRes {
    static constexpr bool PERM = false;
    const float* res; float* out; const float* gate; float gs;
    __device__ __forceinline__ void operator()(const f32x4 (&acc)[2][2][4][2], const pg8::Unit& u, int wr, int wc, int fr, int fq) const {
        const int row0 = u.pm * 256 + wr * 64 + fr, col0 = u.pn * 256 + wc * 32 + 4 * fq;
        const float* gp = gate + (size_t)(u.pm >> 5) * (NMOD * D) + col0;
        f32x4 gv[2][2];
#pragma unroll
        for (int bj = 0; bj < 2; ++bj)
#pragma unroll
            for (int n = 0; n < 2; ++n) gv[bj][n] = *(const f32x4*)(gp + bj * 128 + n * 16) * gs;
#pragma unroll
        for (int ai = 0; ai < 2; ++ai)
#pragma unroll
            for (int m = 0; m < 4; ++m) {
                const size_t off = (size_t)(row0 + ai * 128 + m * 16) * D + col0;
#pragma unroll
                for (int bj = 0; bj < 2; ++bj)
#pragma unroll
                    for (int n = 0; n < 2; ++n) {
                        const f32x4 r = *(const f32x4*)(res + off + bj * 128 + n * 16);
                        *(f32x4*)(out + off + bj * 128 + n * 16) = r * DN_ALPHA + gv[bj][n] * acc[ai][bj][m][n];
                    }
                if (m & 1) asm volatile("" ::: "memory");
            }
    }
};
__device__ __forceinline__ void store8(bf16_t* p, const f32x4& a, const f32x4& b) {
    u32x4 w; w.x = pk2(a[0], a[1]); w.y = pk2(a[2], a[3]); w.z = pk2(b[0], b[1]); w.w = pk2(b[2], b[3]);
    *(u32x4*)p = w;
}
struct EpiGla {
    static constexpr bool PERM = true;
    bf16_t *Q, *Kk, *V, *R; float* GLR;
    __device__ __forceinline__ void operator()(const f32x4 (&acc)[2][2][4][2], const pg8::Unit& u, int wr, int wc, int fr, int fq) const {
        const int row0 = u.pm * 256 + wr * 64 + fr;
        if (u.pn < 24) {
            bf16_t* base; int ldc, colt;
            if (u.pn < 4) { base = Q; ldc = 1024; colt = u.pn * 256; }
            else if (u.pn < 8) { base = Kk; ldc = 1024; colt = (u.pn - 4) * 256; }
            else if (u.pn < 16) { base = V; ldc = 2048; colt = (u.pn - 8) * 256; }
            else { base = R; ldc = 2048; colt = (u.pn - 16) * 256; }
            const int col0 = colt + wc * 32 + 8 * fq;
#pragma unroll
            for (int ai = 0; ai < 2; ++ai)
#pragma unroll
                for (int m = 0; m < 4; ++m) {
                    bf16_t* rowp = base + (size_t)(row0 + ai * 128 + m * 16) * ldc + col0;
#pragma unroll
                    for (int bj = 0; bj < 2; ++bj) store8(rowp + bj * 128, acc[ai][bj][m][0], acc[ai][bj][m][1]);
                }
        } else if (wc == 0 && fq < 2) {
#pragma unroll
            for (int ai = 0; ai < 2; ++ai)
#pragma unroll
                for (int m = 0; m < 4; ++m) {
                    float* rowp = GLR + (size_t)(row0 + ai * 128 + m * 16) * 16 + 8 * fq;
                    *(f32x4*)rowp = acc[ai][0][m][0]; *(f32x4*)(rowp + 4) = acc[ai][0][m][1];
                }
        }
    }
};
struct EpiDil {
    static constexpr bool PERM = true;
    bf16_t *DQ, *DK, *DV; const float* cosT; const float* sinT;
    __device__ __forceinline__ void operator()(const f32x4 (&acc)[2][2][4][2], const pg8::Unit& u, int wr, int wc, int fr, int fq) const {
        const int row0 = u.pm * 256 + wr * 64 + fr;
        const int seg = u.pn / 12, colt = (u.pn - seg * 12) * 256;
        bf16_t* base = DQ + (size_t)seg * ((size_t)TH * 3072);
        const int col0 = colt + wc * 32 + 8 * fq;
        if (seg == 2) {
#pragma unroll
            for (int ai = 0; ai < 2; ++ai)
#pragma unroll
                for (int m = 0; m < 4; ++m) {
                    bf16_t* rowp = base + (size_t)(row0 + ai * 128 + m * 16) * 3072 + col0;
#pragma unroll
                    for (int bj = 0; bj < 2; ++bj) store8(rowp + bj * 128, acc[ai][bj][m][0], acc[ai][bj][m][1]);
                }
        } else {
            const float sc = seg == 0 ? 0.08838834764831845f : 1.0f;
            const int g4 = 4 * (4 * wc + fq);
#pragma unroll
            for (int ai = 0; ai < 2; ++ai)
#pragma unroll
                for (int m = 0; m < 4; ++m) {
                    const int row = row0 + ai * 128 + m * 16;
                    const f32x4 c4 = *(const f32x4*)(cosT + (size_t)row * 64 + g4) * sc, s4 = *(const f32x4*)(sinT + (size_t)row * 64 + g4) * sc;
                    bf16_t* rowp = base + (size_t)row * 3072 + col0;
#pragma unroll
                    for (int bj = 0; bj < 2; ++bj) {
                        const f32x4 x1 = acc[ai][bj][m][0], x2 = acc[ai][bj][m][1];
                        store8(rowp + bj * 128, x1 * c4 - x2 * s4, x2 * c4 + x1 * s4);
                    }
                    asm volatile("" ::: "memory");
                }
        }
    }
};
struct EpiGates {
    static constexpr bool PERM = true;
    bf16_t *SGA, *SGB;
    __device__ __forceinline__ void operator()(const f32x4 (&acc)[2][2][4][2], const pg8::Unit& u, int wr, int wc, int fr, int fq) const {
        const int row0 = u.pm * 256 + wr * 64 + fr;
        bf16_t* base = u.pn < 8 ? SGA : SGB;
        const int col0 = (u.pn & 7) * 256 + wc * 32 + 8 * fq;
#pragma unroll
        for (int ai = 0; ai < 2; ++ai)
#pragma unroll
            for (int m = 0; m < 4; ++m) {
                bf16_t* rowp = base + (size_t)(row0 + ai * 128 + m * 16) * D + col0;
#pragma unroll
                for (int bj = 0; bj < 2; ++bj) {
                    f32x4 a = acc[ai][bj][m][0], b = acc[ai][bj][m][1];
#pragma unroll
                    for (int j = 0; j < 4; ++j) { a[j] = sigmoidf_(a[j]); b[j] = sigmoidf_(b[j]); }
                    store8(rowp + bj * 128, a, b);
                }
            }
    }
};
template <bool ADD> struct EpiMul {
    static constexpr bool PERM = true;
    const bf16_t* gate; bf16_t* io;
    __device__ __forceinline__ void operator()(const f32x4 (&acc)[2][2][4][2], const pg8::Unit& u, int wr, int wc, int fr, int fq) const {
        const int row0 = u.pm * 256 + wr * 64 + fr, col0 = u.pn * 256 + wc * 32 + 8 * fq;
#pragma unroll
        for (int ai = 0; ai < 2; ++ai)
#pragma unroll
            for (int m = 0; m < 4; ++m) {
                const size_t off = (size_t)(row0 + ai * 128 + m * 16) * D + col0;
#pragma unroll
                for (int bj = 0; bj < 2; ++bj) {
                    const u32x4 gw = *(const u32x4*)(gate + off + bj * 128);
                    f32x4 a = acc[ai][bj][m][0], b = acc[ai][bj][m][1];
                    a[0] *= bf_lo(gw.x); a[1] *= bf_hi(gw.x); a[2] *= bf_lo(gw.y); a[3] *= bf_hi(gw.y);
                    b[0] *= bf_lo(gw.z); b[1] *= bf_hi(gw.z); b[2] *= bf_lo(gw.w); b[3] *= bf_hi(gw.w);
                    if (ADD) {
                        const u32x4 tw = *(const u32x4*)(io + off + bj * 128);
                        a[0] += bf_lo(tw.x); a[1] += bf_hi(tw.x); a[2] += bf_lo(tw.y); a[3] += bf_hi(tw.y);
                        b[0] += bf_lo(tw.z); b[1] += bf_hi(tw.z); b[2] += bf_lo(tw.w); b[3] += bf_hi(tw.w);
                    }
                    store8(io + off + bj * 128, a, b);
                }
            }
    }
};

__device__ __forceinline__ void mods_item(CArgs a, float* mods, LAS float* scr, int item, int lane) {
    const int cg_ = item % 72, kc = item / 72, k0 = kc * 128, col = cg_ * 256 + 4 * lane;
#pragma unroll
    for (int i = 0; i < 8; ++i) { const int e = lane + 64 * i, b = e >> 7, kk = e & 127; scr[e] = siluf_(a->c[b * D + k0 + kk]); }
    asm volatile("s_waitcnt lgkmcnt(0)" ::: "memory");
    f32x4 s0 = {0, 0, 0, 0}, s1 = s0, s2 = s0, s3 = s0;
    const float* wp = a->w_ada + (size_t)k0 * (NMOD * D) + col;
#pragma unroll 8
    for (int kk = 0; kk < 128; ++kk) {
        const f32x4 w = __builtin_nontemporal_load((const f32x4*)(wp + (size_t)kk * (NMOD * D)));
        s0 += w * scr[kk]; s1 += w * scr[128 + kk]; s2 += w * scr[256 + kk]; s3 += w * scr[384 + kk];
    }
    if (kc == 0) { const f32x4 bb = *(const f32x4*)(a->b_ada + col); s0 += bb; s1 += bb; s2 += bb; s3 += bb; }
#pragma unroll
    for (int j = 0; j < 4; ++j) {
        atomicAdd(mods + 0 * NMOD * D + col + j, s0[j]); atomicAdd(mods + 1 * NMOD * D + col + j, s1[j]);
        atomicAdd(mods + 2 * NMOD * D + col + j, s2[j]); atomicAdd(mods + 3 * NMOD * D + col + j, s3[j]);
    }
    asm volatile("s_waitcnt lgkmcnt(0)" ::: "memory");
}
__device__ __forceinline__ int srccol(int mode, int n, int src0) {
    if (mode == 0) return src0 + n;
    if (mode == 1) { const int head = n >> 7, p = n & 127, g = p >> 3, nn = (p >> 2) & 1, j = p & 3; return src0 + head * 128 + 4 * g + j + 64 * nn; }
    const int pn = n >> 8, rr = n & 255; return rr < 128 ? pn * 128 + rr : FF + pn * 128 + rr - 128;
}
__device__ __forceinline__ void transpose_item(const float* W, int K, int N, bf16_t* WT, int dst0, int src0, int mode, int nblk, LAS float* scr, int item, int lane) {
    const int kb = item / nblk, nb = item % nblk, k0 = 64 * kb, n0 = 32 * nb;
    const int sc = srccol(mode, n0 + (lane & 31), src0);
#pragma unroll 8
    for (int i = 0; i < 32; ++i) { const int kk = 2 * i + (lane >> 5); scr[kk * 33 + (lane & 31)] = __builtin_nontemporal_load(W + (size_t)(k0 + kk) * N + sc); }
    asm volatile("s_waitcnt lgkmcnt(0)" ::: "memory");
    const int c = lane & 7;
#pragma unroll
    for (int j = 0; j < 4; ++j) { const int n = (lane >> 3) + 8 * j; const LAS float* s = scr + (8 * c) * 33 + n;
        u32x4 o; o.x = pk2(s[0 * 33], s[1 * 33]); o.y = pk2(s[2 * 33], s[3 * 33]); o.z = pk2(s[4 * 33], s[5 * 33]); o.w = pk2(s[6 * 33], s[7 * 33]);
        *(u32x4*)(WT + (size_t)(dst0 + n0 + n) * K + k0 + 8 * c) = o; }
    asm volatile("s_waitcnt lgkmcnt(0)" ::: "memory");
}
__device__ __forceinline__ bool tj(const float* W, int K, int N, bf16_t* WT, int dst0, int nrows, int src0, int mode, int& r, LAS float* scr, int lane) {
    const int cnt = (K / 64) * (nrows / 32);
    if (r < cnt) { transpose_item(W, K, N, WT, dst0, src0, mode, nrows / 32, scr, r, lane); return true; }
    r -= cnt; return false;
}

__device__ __forceinline__ void modulate_rows(const float* x, const float* mods, int ch_shift, bf16_t* h, int gw, int NGW, int lane) {
    for (int m = gw; m < T; m += NGW) {
        const float* mp = mods + (size_t)(m / SEQ) * (NMOD * D) + ch_shift * D;
        const f32x4* xr = (const f32x4*)(x + (size_t)m * D) + lane;
        u32x2* o8 = (u32x2*)(h + (size_t)m * D) + lane;
#pragma unroll
        for (int j = 0; j < 8; ++j) {
            const f32x4 v = __builtin_nontemporal_load(xr + 64 * j), sh = ((const f32x4*)mp)[lane + 64 * j], sc = ((const f32x4*)(mp + D))[lane + 64 * j];
            const f32x4 r = v * (sc + 1.0f) + sh;
            u32x2 w; w.x = pk2(r[0], r[1]); w.y = pk2(r[2], r[3]); o8[64 * j] = w;
        }
    }
}
__device__ __forceinline__ void ln_rows(float* y, const float* g, const float* bta, const float* mods, int ch_shift, bf16_t* h, int gw, int NGW, int lane) {
    for (int m = gw; m < T; m += NGW) {
        f32x4* yr = (f32x4*)(y + (size_t)m * D) + lane;
        f32x4 v[8]; float s = 0.f;
#pragma unroll
        for (int j = 0; j < 8; ++j) { v[j] = __builtin_nontemporal_load(yr + 64 * j); s += (v[j][0] + v[j][1]) + (v[j][2] + v[j][3]); }
        const float mean = wave_sum(s) * (1.f / D); float s2 = 0.f;
#pragma unroll
        for (int j = 0; j < 8; ++j) { v[j] = v[j] - mean; s2 += (v[j][0] * v[j][0] + v[j][1] * v[j][1]) + (v[j][2] * v[j][2] + v[j][3] * v[j][3]); }
        const float rstd = 1.f / sqrtf(wave_sum(s2) * (1.f / D) + LN_EPS);
#pragma unroll
        for (int j = 0; j < 8; ++j) {
            const f32x4 gg = ((const f32x4*)g)[lane + 64 * j], bb = ((const f32x4*)bta)[lane + 64 * j];
            v[j] = v[j] * rstd * gg + bb; __builtin_nontemporal_store(v[j], yr + 64 * j);
        }
        if (h) {
            const float* mp = mods + (size_t)(m / SEQ) * (NMOD * D) + ch_shift * D;
            u32x2* o8 = (u32x2*)(h + (size_t)m * D) + lane;
#pragma unroll
            for (int j = 0; j < 8; ++j) {
                const f32x4 sh = ((const f32x4*)mp)[lane + 64 * j], sc = ((const f32x4*)(mp + D))[lane + 64 * j];
                const f32x4 r = v[j] * (sc + 1.0f) + sh;
                u32x2 w; w.x = pk2(r[0], r[1]); w.y = pk2(r[2], r[3]); o8[64 * j] = w;
            }
        }
    }
}

constexpr int GP = 264;
constexpr int VP = 72;
__device__ __forceinline__ void gla_prep(CArgs a, LAS unsigned char* lds) {
    unsigned char* ws = a->ws;
    bf16_t* Q = (bf16_t*)(ws + WS_Q); bf16_t* Kk = (bf16_t*)(ws + WS_K); const float* GLR = (const float*)(ws + WS_GLR);
    bf16_t* AIN = (bf16_t*)(ws + WS_AIN); float* DEC = (float*)(ws + WS_DEC);
    const int tid = tid_local(), lane = tid & 63, wid = __builtin_amdgcn_readfirstlane(tid >> 6), fr = lane & 15, fq = lane >> 4;
    LAS unsigned char* Qd = lds; LAS unsigned char* Ki = lds + 64 * GP * 2; LAS float* tot = (LAS float*)(lds + 2 * 64 * GP * 2);
    const int dk = tid & 255, half = __builtin_amdgcn_readfirstlane(tid >> 8);
    for (int unit = blockIdx.x; unit < NB * 4 * 128; unit += gridDim.x) {
        const int c = unit & 127, bh = unit >> 7, h = bh & 3, b = bh >> 2;
        const int t0 = b * SEQ + c * 64;
        LAS float* glr_l = (LAS float*)(lds + 2 * 64 * GP * 2 + 2048);
        if (tid < 256) *(LAS f32x4*)(glr_l + tid * 4) = *(const f32x4*)(GLR + (size_t)t0 * 16 + tid * 4);
        float w2[16];
#pragma unroll
        for (int r = 0; r < 16; ++r) w2[r] = a->w_alpha2[r * 1024 + h * 256 + dk];
        const float ba = a->b_alpha[h * 256 + dk];
        float la[32], qv[32], kv[32]; float run = 0.f;
#pragma unroll
        for (int i = 0; i < 32; ++i) {
            const size_t gi = (size_t)(t0 + half * 32 + i) * 1024 + h * 256 + dk;
            qv[i] = bf2f(Q[gi]); kv[i] = bf2f(Kk[gi]);
        }
        __syncthreads();
#pragma unroll
        for (int i = 0; i < 32; ++i) {
            const LAS f32x4* gp = (const LAS f32x4*)(glr_l + (half * 32 + i) * 16);
            const f32x4 g0 = gp[0], g1 = gp[1], g2 = gp[2], g3 = gp[3];
            float z = ba;
#pragma unroll
            for (int j = 0; j < 4; ++j) { z += g0[j] * w2[j]; z += g1[j] * w2[4 + j]; z += g2[j] * w2[8 + j]; z += g3[j] * w2[12 + j]; }
            const float ls = fminf(z, 0.f) - __logf(1.0f + __expf(-fabsf(z)));
            run += ls * (1.0f / 16.0f); la[i] = run;
        }
        tot[half * 256 + dk] = run;
        __syncthreads();
        const float t0s = tot[dk], t1s = tot[256 + dk];
        const float boff = half ? t0s : 0.f, blast = t0s + t1s, eblast = __expf(blast);
        if (half == 0) DEC[(size_t)unit * 256 + dk] = eblast;
        unsigned kew[16]; float kef_prev = 0.f;
#pragma unroll
        for (int i = 0; i < 32; ++i) {
            const int s = half * 32 + i;
            const float eb = __expf(boff + la[i]);
            const float kif = kv[i] * fast_rcp(eb);
            const bf16_t qd = f2bf(qv[i] * eb * 0.0625f), ki = f2bf(kif);
            *(LAS bf16_t*)(Qd + (s * GP + dk) * 2) = qd; *(LAS bf16_t*)(Ki + (s * GP + dk) * 2) = ki;
            const float kef = kif * eblast;
            if (i & 1) kew[i >> 1] = pk2(kef_prev, kef);
            kef_prev = kef;
        }
        {
            const int jj = (dk >> 4) * 2 + half;
#pragma unroll
            for (int v = 0; v < 4; ++v) { const int l = v * 16 + (dk & 15);
                *(u32x4*)(Kk + (size_t)(t0 + 2 * jj + (l >> 5)) * 1024 + h * 256 + (l & 31) * 8) = (u32x4){kew[4 * v], kew[4 * v + 1], kew[4 * v + 2], kew[4 * v + 3]}; }
        }
        __syncthreads();
#pragma unroll
        for (int i = 0; i < 4; ++i) { const int id = tid + 512 * i, j = id >> 6, l = id & 63;
            const u32x4 w = *(const LAS u32x4*)(Qd + ((16 * (j >> 3) + (l & 15)) * GP + 32 * (j & 7) + 8 * (l >> 4)) * 2);
            *(u32x4*)(Q + (size_t)(t0 + 2 * j + (l >> 5)) * 1024 + h * 256 + (l & 31) * 8) = w; }
        const int rt = wid >> 1, ct0 = (wid & 1) * 2;
        f32x4 o[2] = {{0, 0, 0, 0}, {0, 0, 0, 0}};
#pragma unroll
        for (int kk = 0; kk < 8; ++kk) {
            const bf16x8 af = *(const LAS bf16x8*)(Qd + ((16 * rt + fr) * GP + 32 * kk + 8 * fq) * 2);
#pragma unroll
            for (int c2 = 0; c2 < 2; ++c2) {
                const bf16x8 bfr = *(const LAS bf16x8*)(Ki + ((16 * (ct0 + c2) + fr) * GP + 32 * kk + 8 * fq) * 2);
                o[c2] = MFMA16(af, bfr, o[c2]);
            }
        }
#pragma unroll
        for (int c2 = 0; c2 < 2; ++c2)
#pragma unroll
            for (int j = 0; j < 4; ++j) {
                const int s = 16 * rt + 4 * fq + j, sp = 16 * (ct0 + c2) + fr;
                AIN[(size_t)unit * 4096 + (((rt * 2 + (sp >> 5)) * 64 + ((sp & 31) >> 3) * 16 + (s & 15)) << 3) + (sp & 7)] = f2bf(sp <= s ? o[c2][j] : 0.f);
            }
        __syncthreads();
    }
}
__device__ __forceinline__ void gla_seq(CArgs a, LAS unsigned char* lds) {
    const int blk = blockIdx.x; if (blk >= 128) return;
    unsigned char* ws = a->ws;
    const bf16_t* Q = (const bf16_t*)(ws + WS_Q); const bf16_t* Kk = (const bf16_t*)(ws + WS_K); const bf16_t* V = (const bf16_t*)(ws + WS_V);
    const bf16_t* AIN = (const bf16_t*)(ws + WS_AIN); const float* DEC = (const float*)(ws + WS_DEC); float* ORAW = (float*)(ws + WS_ORAW);
    const int bh = (blk & 7) + 8 * (blk >> 6), dvs = (blk >> 3) & 7, b = bh >> 2, h = bh & 3;
    const int tid = tid_local(), lane = tid & 63, wid = __builtin_amdgcn_readfirstlane(tid >> 6), fr = lane & 15, fq = lane >> 4, qq = fr >> 2, pp = lane & 3;
    constexpr int VB = 64 * VP * 2, SBB = 64 * GP * 2;
    LAS unsigned char* Vl = lds; LAS unsigned char* Sb = lds + 2 * VB;
    for (int e = tid; e < SBB / 16; e += 512) *(LAS u32x4*)(Sb + SBB + e * 16) = (u32x4){0, 0, 0, 0};
    f32x4 S[2][4];
#pragma unroll
    for (int r2 = 0; r2 < 2; ++r2)
#pragma unroll
        for (int ct = 0; ct < 4; ++ct) S[r2][ct] = (f32x4){0, 0, 0, 0};
    const int unit0 = bh * 128, vrow = tid >> 3, vch = tid & 7, rt = wid >> 1, ct0 = (wid & 1) * 2;
    const int dk0 = 16 * (2 * wid) + fr, dk1 = dk0 + 16;
    const size_t fragoff = (size_t)(lane >> 5) * 1024 + h * 256 + (lane & 31) * 8;
    const size_t voff = (size_t)vrow * 2048 + h * 512 + dvs * 64 + vch * 8;
    const int doff = 16 * (2 * wid) + 4 * fq;
    bf16x8 nq[8], na[2], nk[2][2]; f32x4 nd[2]; u32x4 nv;
#define GLA_LOAD(c) do { const size_t tb_ = (size_t)(b * SEQ + (c) * 64); const size_t ub_ = (size_t)(unit0 + (c)); \
        _Pragma("unroll") for (int kk = 0; kk < 8; ++kk) nq[kk] = *(const bf16x8*)(Q + (tb_ + 2 * (rt * 8 + kk)) * 1024 + fragoff); \
        _Pragma("unroll") for (int kk = 0; kk < 2; ++kk) { na[kk] = *(const bf16x8*)(AIN + ub_ * 4096 + ((rt * 2 + kk) * 64 + lane) * 8); \
            nk[0][kk] = *(const bf16x8*)(Kk + (tb_ + 2 * ((2 * wid) * 2 + kk)) * 1024 + fragoff); nk[1][kk] = *(const bf16x8*)(Kk + (tb_ + 2 * ((2 * wid + 1) * 2 + kk)) * 1024 + fragoff); } \
        nd[0] = *(const f32x4*)(DEC + ub_ * 256 + doff); nd[1] = *(const f32x4*)(DEC + ub_ * 256 + doff + 16); } while (0)
    nv = *(const u32x4*)(V + (size_t)(b * SEQ) * 2048 + voff);
    GLA_LOAD(0);
    *(LAS u32x4*)(Vl + (vrow * VP + vch * 8) * 2) = nv;
    __syncthreads();
    for (int c = 0; c < 128; ++c) {
        const int pb = c & 1;
        bf16x8 cq[8], ca[2], ck[2][2]; f32x4 cd[2];
#pragma unroll
        for (int kk = 0; kk < 8; ++kk) cq[kk] = nq[kk];
#pragma unroll
        for (int kk = 0; kk < 2; ++kk) { ca[kk] = na[kk]; ck[0][kk] = nk[0][kk]; ck[1][kk] = nk[1][kk]; }
        cd[0] = nd[0]; cd[1] = nd[1];
        if (c + 1 < 128) { nv = *(const u32x4*)(V + (size_t)(b * SEQ + (c + 1) * 64) * 2048 + voff); GLA_LOAD(c + 1); }
        const LAS unsigned char* Vc = Vl + pb * VB; const LAS unsigned char* Sp = Sb + (pb ^ 1) * SBB;
        {
            f32x4 o[2] = {{0, 0, 0, 0}, {0, 0, 0, 0}};
#pragma unroll
            for (int kk = 0; kk < 2; ++kk)
#pragma unroll
                for (int c2 = 0; c2 < 2; ++c2) {
                    const LAS unsigned char* vp = Vc + ((32 * kk + 8 * fq + qq) * VP + 16 * (ct0 + c2) + 4 * pp) * 2;
                    o[c2] = MFMA16(cat8(tr4(vp), tr4(vp + 4 * VP * 2)), ca[kk], o[c2]);
                }
#pragma unroll
            for (int kk = 0; kk < 8; ++kk)
#pragma unroll
                for (int c2 = 0; c2 < 2; ++c2) {
                    const bf16x8 bfr = *(const LAS bf16x8*)(Sp + ((16 * (ct0 + c2) + fr) * GP + 32 * kk + 8 * fq) * 2);
                    o[c2] = MFMA16(bfr, cq[kk], o[c2]);
                }
            const int t0 = b * SEQ + c * 64;
#pragma unroll
            for (int c2 = 0; c2 < 2; ++c2)
                *(f32x4*)(ORAW + (size_t)(t0 + 16 * rt + fr) * 2048 + h * 512 + dvs * 64 + 16 * (ct0 + c2) + 4 * fq) = o[c2];
        }
        {
#pragma unroll
            for (int r2 = 0; r2 < 2; ++r2)
#pragma unroll
                for (int ct = 0; ct < 4; ++ct) S[r2][ct] = S[r2][ct] * cd[r2];
#pragma unroll
            for (int kk = 0; kk < 2; ++kk)
#pragma unroll
                for (int ct = 0; ct < 4; ++ct) {
                    const LAS unsigned char* vp = Vc + ((32 * kk + 8 * fq + qq) * VP + 16 * ct + 4 * pp) * 2;
                    const bf16x8 bfr = cat8(tr4(vp), tr4(vp + 4 * VP * 2));
#pragma unroll
                    for (int r2 = 0; r2 < 2; ++r2) S[r2][ct] = MFMA16(ck[r2][kk], bfr, S[r2][ct]);
                }
        }
        LAS unsigned char* Sn = Sb + pb * SBB;
#pragma unroll
        for (int r2 = 0; r2 < 2; ++r2)
#pragma unroll
            for (int ct = 0; ct < 4; ++ct) {
                u32x2 w; w.x = pk2(S[r2][ct][0], S[r2][ct][1]); w.y = pk2(S[r2][ct][2], S[r2][ct][3]);
                *(LAS u32x2*)(Sn + ((16 * ct + fr) * GP + 16 * (2 * wid + r2) + 4 * fq) * 2) = w;
            }
        if (c + 1 < 128) *(LAS u32x4*)(Vl + (pb ^ 1) * VB + (vrow * VP + vch * 8) * 2) = nv;
        __syncthreads();
    }
#undef GLA_LOAD
}
__device__ __forceinline__ void gla_norm(CArgs a, int gw, int NGW, int lane) {
    unsigned char* ws = a->ws;
    const float* ORAW = (const float*)(ws + WS_ORAW); const bf16_t* R = (const bf16_t*)(ws + WS_R); bf16_t* OA = (bf16_t*)(ws + WS_OA);
    for (int m = gw; m < T; m += NGW) {
        const f32x4* orow = (const f32x4*)(ORAW + (size_t)m * 2048) + lane;
        const u32x2* rrow = (const u32x2*)(R + (size_t)m * 2048) + lane;
        u32x2* out = (u32x2*)(OA + (size_t)m * 2048) + lane;
        f32x4 v[8];
#pragma unroll
        for (int j = 0; j < 8; ++j) v[j] = __builtin_nontemporal_load(orow + 64 * j);
#pragma unroll
        for (int hh = 0; hh < 4; ++hh) {
            const f32x4 x0 = v[2 * hh], x1 = v[2 * hh + 1];
            float s = (x0[0] * x0[0] + x0[1] * x0[1]) + (x0[2] * x0[2] + x0[3] * x0[3]) + (x1[0] * x1[0] + x1[1] * x1[1]) + (x1[2] * x1[2] + x1[3] * x1[3]);
            const float rs = 1.0f / sqrtf(wave_sum(s) * (1.0f / 512.0f) + LN_EPS);
#pragma unroll
            for (int jj = 0; jj < 2; ++jj) {
                const int j = 2 * hh + jj;
                const f32x4 gg = ((const f32x4*)a->gla_g)[lane + 64 * j];
                const u32x2 rw = __builtin_nontemporal_load(rrow + 64 * j);
                const float r0 = bf_lo(rw.x), r1 = bf_hi(rw.x), r2 = bf_lo(rw.y), r3 = bf_hi(rw.y);
                const f32x4 x = v[j] * rs * gg;
                u32x2 w; w.x = pk2(x[0] * siluf_(r0), x[1] * siluf_(r1)); w.y = pk2(x[2] * siluf_(r2), x[3] * siluf_(r3));
                out[64 * j] = w;
            }
        }
    }
}
__device__ __forceinline__ void rope_tables(CArgs a) {
    float* cosT = (float*)(a->ws + WS_COS); float* sinT = (float*)(a->ws + WS_SIN);
    const size_t n = (size_t)T * 64;
    for (size_t e = (size_t)blockIdx.x * 512 + threadIdx.x; e < n; e += (size_t)gridDim.x * 512) {
        const int t = (int)(e >> 6), i = (int)(e & 63);
        const float fr = (float)exp2(-(double)i * (13.287712379549449 / 64.0));
        const float pos = (float)a->pos[t];
        const float ang = pos * fr;
        double rev = (double)ang * 0.15915494309189535; rev -= floor(rev);
        const float rv = (float)rev;
        cosT[e] = __builtin_amdgcn_cosf(rv); sinT[e] = __builtin_amdgcn_sinf(rv);
    }
}

constexpr int KP = 136;
__device__ __forceinline__ void dil_attn(CArgs a, LAS unsigned char* lds) {
    unsigned char* ws = a->ws;
    const bf16_t* DQ = (const bf16_t*)(ws + WS_DQ); const bf16_t* DK = (const bf16_t*)(ws + WS_DK); const bf16_t* DV = (const bf16_t*)(ws + WS_DV);
    bf16_t* OG = (bf16_t*)(ws + WS_OG); float* LSE = (float*)(ws + WS_LSE);
    const int tid = tid_local(), lane = tid & 63, wid = tid >> 6  , fr = lane & 15, fq = lane >> 4, qq = fr >> 2, pp = lane & 3;
    LAS unsigned char* Kt = lds; LAS unsigned char* Vt = lds + 256 * KP * 2;
    const int vcu = (gridDim.x & 7) == 0 ? (int)((blockIdx.x & 7) * (gridDim.x >> 3) + (blockIdx.x >> 3)) : (int)blockIdx.x;
    for (int unit = vcu; unit < 2 * 3 * 8 * 64; unit += gridDim.x) {
        const int u64 = unit & 63, hh = (unit >> 6) & 7, g = (unit >> 9) % 3, bl = unit / 1536;
        const int r = 1 << (2 * g), nb = 64 >> (2 * g), rc = u64 / nb, n = u64 % nb;
        const int tb = bl * SEQ, cb = g * 1024 + hh * 128;
        {
            const int ch = tid & 15, r0 = tid >> 4;
            const bool hasprev = n > 0;
            const size_t rowstep = (size_t)32 * r * 3072;
            const bf16_t* kp = DK + (size_t)(tb + (128 * (n - 1) + r0) * r + rc) * 3072 + cb + ch * 8;
            const bf16_t* vp = DV + (size_t)(tb + (128 * (n - 1) + r0) * r + rc) * 3072 + cb + ch * 8;
            u32x4 kr[8];
#pragma unroll
            for (int i = 0; i < 4; ++i) kr[i] = (u32x4){0, 0, 0, 0};
            if (hasprev) {
#pragma unroll
                for (int i = 0; i < 4; ++i) kr[i] = *(const u32x4*)(kp + i * rowstep);
            }
#pragma unroll
            for (int i = 4; i < 8; ++i) kr[i] = *(const u32x4*)(kp + i * rowstep);
#pragma unroll
            for (int i = 0; i < 8; ++i) *(LAS u32x4*)(Kt + ((r0 + 32 * i) * KP + ch * 8) * 2) = kr[i];
#pragma unroll
            for (int i = 0; i < 4; ++i) kr[i] = (u32x4){0, 0, 0, 0};
            if (hasprev) {
#pragma unroll
                for (int i = 0; i < 4; ++i) kr[i] = *(const u32x4*)(vp + i * rowstep);
            }
#pragma unroll
            for (int i = 4; i < 8; ++i) kr[i] = *(const u32x4*)(vp + i * rowstep);
#pragma unroll
            for (int i = 0; i < 8; ++i) *(LAS u32x4*)(Vt + ((r0 + 32 * i) * KP + ch * 8) * 2) = kr[i];
        }
        bf16x8 qf[4];
        { const size_t tq = (size_t)(tb + (128 * n + 16 * wid + fr) * r + rc);
#pragma unroll
          for (int kk = 0; kk < 4; ++kk) qf[kk] = *(const bf16x8*)(DQ + tq * 3072 + cb + 32 * kk + 8 * fq); }
        __syncthreads();
        f32x4 sc[10];
#pragma unroll
        for (int i = 0; i < 10; ++i) {
            const int kt = wid + i, ktc = kt < 15 ? kt : 15;
            f32x4 acc = {0, 0, 0, 0};
#pragma unroll
            for (int kk = 0; kk < 4; ++kk) {
                const bf16x8 af = *(const LAS bf16x8*)(Kt + ((16 * ktc + fr) * KP + 32 * kk + 8 * fq) * 2);
                acc = MFMA16(af, qf[kk], acc);
            }
            sc[i] = acc;
        }
        const int qi = 16 * wid + fr;
        const int klo = (n > 0 || qi >= 128) ? qi : 128, khi = qi + 128 < 255 ? qi + 128 : 255;
        float mx = -3.0e38f;
#pragma unroll
        for (int i = 0; i < 10; ++i)
#pragma unroll
            for (int j = 0; j < 4; ++j) {
                const int kj = 16 * (wid + i) + 4 * fq + j;
                const int dlo = kj - klo, dhi = khi - kj;
                const int dm = (dlo < dhi ? dlo : dhi) >> 31;
                sc[i][j] = fmaf((float)dm, 3.0e38f, sc[i][j]);
                mx = fmaxf(mx, sc[i][j]);
            }
        mx = fmaxf(mx, __shfl_xor(mx, 16)); mx = fmaxf(mx, __shfl_xor(mx, 32));
        float den = 0.f;
#pragma unroll
        for (int i = 0; i < 10; ++i)
#pragma unroll
            for (int j = 0; j < 4; ++j) { const float p = __expf(sc[i][j] - mx); sc[i][j] = p; den += p; }
        den += __shfl_xor(den, 16); den += __shfl_xor(den, 32);
        f32x4 o[8];
#pragma unroll
        for (int dt = 0; dt < 8; ++dt) o[dt] = (f32x4){0, 0, 0, 0};
#pragma unroll
        for (int pi = 0; pi < 5; ++pi) {
            const int kta = wid + 2 * pi, ktb = kta + 1, ka = kta < 15 ? kta : 15, kb = ktb < 15 ? ktb : 15;
            bf16x8 pf;
            { const unsigned w0 = pk2(sc[2 * pi][0], sc[2 * pi][1]), w1 = pk2(sc[2 * pi][2], sc[2 * pi][3]), w2 = pk2(sc[2 * pi + 1][0], sc[2 * pi + 1][1]), w3 = pk2(sc[2 * pi + 1][2], sc[2 * pi + 1][3]);
              pf = __builtin_bit_cast(bf16x8, (u32x4){w0, w1, w2, w3}); }
#pragma unroll
            for (int dt = 0; dt < 8; ++dt) {
                const LAS unsigned char* va = Vt + ((16 * ka + 4 * fq + qq) * KP + 16 * dt + 4 * pp) * 2;
                const LAS unsigned char* vb = Vt + ((16 * kb + 4 * fq + qq) * KP + 16 * dt + 4 * pp) * 2;
                const bf16x8 bfr = cat8(tr4(va), tr4(vb));
                o[dt] = MFMA16(pf, bfr, o[dt]);
            }
        }
        const float lse_l = mx + __logf(den);
        if (fq == 0) LSE[(size_t)(tb + (128 * n + qi) * r + rc) * 24 + g * 8 + hh] = lse_l;
#pragma unroll
        for (int j = 0; j < 4; ++j) {
            const float dj = __shfl(den, 4 * fq + j);
            const float inv = fast_rcp(dj);
            const size_t tq = (size_t)(tb + (128 * n + 16 * wid + 4 * fq + j) * r + rc);
#pragma unroll
            for (int dt = 0; dt < 8; ++dt) OG[tq * 3072 + cb + 16 * dt + fr] = f2bf(o[dt][j] * inv);
        }
        __syncthreads();
    }
}
__device__ __forceinline__ void dil_merge(CArgs a, int half, int gw, int NGW, int lane) {
    const bf16_t* OG = (const bf16_t*)(a->ws + WS_OG); const float* LSE = (const float*)(a->ws + WS_LSE); bf16_t* OB = (bf16_t*)(a->ws + WS_OB);
    const int hh = lane >> 3, d0 = (lane & 7) * 16;
    for (int m = gw; m < TH; m += NGW) {
        const float l0 = LSE[(size_t)m * 24 + hh], l1 = LSE[(size_t)m * 24 + 8 + hh], l2 = LSE[(size_t)m * 24 + 16 + hh];
        const float mx = fmaxf(l0, fmaxf(l1, l2));
        float w0 = __expf(l0 - mx), w1 = __expf(l1 - mx), w2 = __expf(l2 - mx);
        const float inv = 1.0f / (w0 + w1 + w2); w0 *= inv; w1 *= inv; w2 *= inv;
        const bf16_t* p = OG + (size_t)m * 3072 + hh * 128 + d0;
        bf16_t* o = OB + (size_t)(half * TH + m) * 1024 + hh * 128 + d0;
#pragma unroll
        for (int q = 0; q < 2; ++q) {
            const u32x4 a0 = *(const u32x4*)(p + 8 * q), a1 = *(const u32x4*)(p + 1024 + 8 * q), a2 = *(const u32x4*)(p + 2048 + 8 * q);
            u32x4 w;
            w.x = pk2(w0 * bf_lo(a0.x) + w1 * bf_lo(a1.x) + w2 * bf_lo(a2.x), w0 * bf_hi(a0.x) + w1 * bf_hi(a1.x) + w2 * bf_hi(a2.x));
            w.y = pk2(w0 * bf_lo(a0.y) + w1 * bf_lo(a1.y) + w2 * bf_lo(a2.y), w0 * bf_hi(a0.y) + w1 * bf_hi(a1.y) + w2 * bf_hi(a2.y));
            w.z = pk2(w0 * bf_lo(a0.z) + w1 * bf_lo(a1.z) + w2 * bf_lo(a2.z), w0 * bf_hi(a0.z) + w1 * bf_hi(a1.z) + w2 * bf_hi(a2.z));
            w.w = pk2(w0 * bf_lo(a0.w) + w1 * bf_lo(a1.w) + w2 * bf_lo(a2.w), w0 * bf_hi(a0.w) + w1 * bf_hi(a1.w) + w2 * bf_hi(a2.w));
            *(u32x4*)(o + 8 * q) = w;
        }
    }
}

constexpr size_t WS_BAR = 512 * 1024;
__device__ __forceinline__ void grid_barrier(unsigned* bar, unsigned& gen, unsigned G) {
    asm volatile("s_waitcnt vmcnt(0) lgkmcnt(0)" ::: "memory");
    __syncthreads();
    ++gen;
    if (threadIdx.x == 0) {
        __builtin_amdgcn_fence(__ATOMIC_RELEASE, "agent");
        asm volatile("s_waitcnt vmcnt(0)" ::: "memory");
        if ((G & 7u) == 0u) {
            const unsigned x = blockIdx.x & 7u, per = G >> 3;
            unsigned* cnt1 = bar + 64 * (1 + x); unsigned* cnt2 = bar + 64 * 9; unsigned* rel = bar + 64 * (10 + x);
            const unsigned old = __hip_atomic_fetch_add(cnt1, 1u, __ATOMIC_RELAXED, __HIP_MEMORY_SCOPE_AGENT);
            if (old + 1u == gen * per) {
                __hip_atomic_fetch_add(cnt2, 1u, __ATOMIC_RELAXED, __HIP_MEMORY_SCOPE_AGENT);
                while (__hip_atomic_load(cnt2, __ATOMIC_RELAXED, __HIP_MEMORY_SCOPE_AGENT) < gen * 8u) __builtin_amdgcn_s_sleep(1);
                __hip_atomic_fetch_add(rel, 1u, __ATOMIC_RELAXED, __HIP_MEMORY_SCOPE_AGENT);
            } else {
                while (__hip_atomic_load(rel, __ATOMIC_RELAXED, __HIP_MEMORY_SCOPE_AGENT) < gen) __builtin_amdgcn_s_sleep(1);
            }
        } else {
            __hip_atomic_fetch_add(bar, 1u, __ATOMIC_RELAXED, __HIP_MEMORY_SCOPE_AGENT);
            const unsigned target = gen * G;
            while (__hip_atomic_load(bar, __ATOMIC_RELAXED, __HIP_MEMORY_SCOPE_AGENT) < target) __builtin_amdgcn_s_sleep(2);
        }
        __builtin_amdgcn_fence(__ATOMIC_ACQUIRE, "agent");
        asm volatile("s_waitcnt vmcnt(0)" ::: "memory");
    }
    __syncthreads();
}

#ifndef PH_MASK
#define PH_MASK 0xffffffffu
#endif
#define ON(k) (((PH_MASK) >> (k)) & 1u)
#ifndef GEMM_SP2
#define GEMM_SP2 true
#endif
#ifndef GEMM_ALIGN
#define GEMM_ALIGN true
#endif
__global__ void __launch_bounds__(512, 2) fwd_megakernel(Args a_by_value) {
    extern __shared__ __attribute__((aligned(16))) unsigned char lds_raw[];
    LAS unsigned char* lds = (LAS unsigned char*)lds_raw;
    cg::grid_group grid = cg::this_grid();
    const int tid = tid_local(), lane = tid & 63, wave = __builtin_amdgcn_readfirstlane(tid >> 6);
    const int G = gridDim.x, gw = blockIdx.x * 8 + wave, NGW = G * 8;
    const CArgs ap0 = (CArgs)__builtin_amdgcn_kernarg_segment_ptr();
    LAS float* scr = (LAS float*)(lds + wave * 16384);
#define PH_BEGIN const CArgs a = launder(ap0); unsigned char* const ws = a->ws; float* const mods = (float*)(ws + WS_MODS); (void)mods;
#define Wgu ((bf16_t*)(ws + WS_WGU))
#define Wd ((bf16_t*)(ws + WS_WD))
#define Win ((bf16_t*)(ws + WS_WIN))
#define Wa ((bf16_t*)(ws + WS_WA))
#define Wb ((bf16_t*)(ws + WS_WB))
#define Wo ((bf16_t*)(ws + WS_WO))
#define H ((bf16_t*)(ws + WS_H))
#define ACT ((bf16_t*)(ws + WS_ACT))
    using pg8::Gemm; using pg8::StaticOrder;
    unsigned bar_gen = 0;
    {
        unsigned char* w0 = launder(ap0)->ws;
        const int gid = (int)blockIdx.x * 512 + tid;
        if (gid < (NB * NMOD * D) / 4) ((u32x4*)(w0 + WS_MODS))[gid] = (u32x4){0, 0, 0, 0};
        if (blockIdx.x == 0) for (int i = tid; i < 64 * 20; i += 512) ((unsigned*)(w0 + WS_BAR))[i] = 0u;
        asm volatile("s_waitcnt vmcnt(0)" ::: "memory");
    }
    grid.sync();
#define GRID_SYNC() grid_barrier((unsigned*)(launder(ap0)->ws + WS_BAR), bar_gen, (unsigned)G)

    { PH_BEGIN
    if (ON(0)) for (int it = gw; it < 72 * 16; it += NGW) mods_item(a, mods, scr, it, lane);
    if (ON(0)) {
        constexpr int total = (D / 64) * (2 * FF / 32);
        for (int it = gw; it < total; it += NGW) { int r = it; tj(a->w_gu1, D, 2 * FF, Wgu, 0, 2 * FF, 0, 2, r, scr, lane); }
    }
    }
    GRID_SYNC();
    { PH_BEGIN
    if (ON(1)) modulate_rows(a->x, mods, 0, H, gw, NGW, lane);
    if (ON(1)) {
        constexpr int total = (FF / 64) * (D / 32) + (D / 64) * ((6144 + 32) / 32);
        for (int it = gw; it < total; it += NGW) {
            int r = it;
            if (tj(a->w_d1, FF, D, Wd, 0, D, 0, 0, r, scr, lane)) continue;
            tj(a->w_in, D, WIN_SRC, Win, WR_GLA, 6144 + 32, 0, 0, r, scr, lane);
        }
    }
    }
    GRID_SYNC();
    { PH_BEGIN
    if (ON(2)) { Gemm g{H, Wgu, T, 2 * FF, D}; StaticOrder S; S.init(T, 2 * FF, G, (int)blockIdx.x); EpiGU E{ACT};
      pg8::gemm_phase<EpiGU, StaticOrder, GEMM_ALIGN, GEMM_SP2>(lds, g, S, E); }
    }
    GRID_SYNC();
    { PH_BEGIN
    if (ON(3)) { Gemm g{ACT, Wd, T, D, FF}; StaticOrder S; S.init(T, D, G, (int)blockIdx.x); EpiRes E{a->x, a->out, mods + 2 * D, 0.5f};
      pg8::gemm_phase<EpiRes, StaticOrder, GEMM_ALIGN, GEMM_SP2>(lds, g, S, E); }
    }
    GRID_SYNC();
    { PH_BEGIN
    if (ON(4)) ln_rows(a->out, a->ln1_g, a->ln1_b, mods, 3, H, gw, NGW, lane);
    }
    GRID_SYNC();
    { PH_BEGIN
    if (ON(5)) { Gemm g{H, Win + (size_t)WR_GLA * D, T, 25 * 256, D}; StaticOrder S; S.init(T, 25 * 256, G, (int)blockIdx.x);
      EpiGla E{(bf16_t*)(ws + WS_Q), (bf16_t*)(ws + WS_K), (bf16_t*)(ws + WS_V), (bf16_t*)(ws + WS_R), (float*)(ws + WS_GLR)};
      pg8::gemm_phase<EpiGla, StaticOrder, GEMM_ALIGN, GEMM_SP2>(lds, g, S, E); }
    }
    GRID_SYNC();
    { PH_BEGIN
    if (ON(6)) gla_prep(a, lds);
    }
    GRID_SYNC();
    { PH_BEGIN
    if (ON(7)) {
        if (blockIdx.x < 128) gla_seq(a, lds);
        else {
            const int gw2 = (blockIdx.x - 128) * 8 + wave, NGW2 = (G - 128) * 8;
            constexpr int total = (D / 64) * ((3072 + 3072 + 7168) / 32) + (2048 / 64) * (D / 32) + (1024 / 64) * (D / 32) + (D / 64) * (D / 32) + (D / 64) * (2 * FF / 32) + (FF / 64) * (D / 32);
            for (int it = gw2; it < total; it += NGW2) {
                int r = it;
                if (tj(a->w_in, D, WIN_SRC, Win, WR_DQ, 3072, 6160, 1, r, scr, lane)) continue;
                if (tj(a->w_in, D, WIN_SRC, Win, WR_DK, 3072, 9232, 1, r, scr, lane)) continue;
                if (tj(a->w_in, D, WIN_SRC, Win, WR_DV, 3072 + 4096, 12304, 0, r, scr, lane)) continue;
                if (tj(a->w_a, 2048, D, Wa, 0, D, 0, 0, r, scr, lane)) continue;
                if (tj(a->w_b, 1024, D, Wb, 0, D, 0, 0, r, scr, lane)) continue;
                if (tj(a->w_o, D, D, Wo, 0, D, 0, 0, r, scr, lane)) continue;
                if (tj(a->w_gu2, D, 2 * FF, Wgu, 0, 2 * FF, 0, 2, r, scr, lane)) continue;
                tj(a->w_d2, FF, D, Wd, 0, D, 0, 0, r, scr, lane);
            }
        }
    }
    }
    GRID_SYNC();
    { PH_BEGIN
    if (ON(8)) gla_norm(a, gw, NGW, lane);
    if (ON(9)) rope_tables(a);
    }
    GRID_SYNC();
    for (int half = 0; half < 2; ++half) {
        { PH_BEGIN
        if (ON(11) && half == 1) dil_merge(a, 0, gw, NGW, lane);
        if (ON(9)) { Gemm g{H + (size_t)half * TH * D, Win + (size_t)WR_DQ * D, TH, 36 * 256, D}; StaticOrder S; S.init(TH, 36 * 256, G, (int)blockIdx.x);
          EpiDil E{(bf16_t*)(ws + WS_DQ), (bf16_t*)(ws + WS_DK), (bf16_t*)(ws + WS_DV), (const float*)(ws + WS_COS) + (size_t)half * TH * 64, (const float*)(ws + WS_SIN) + (size_t)half * TH * 64};
          pg8::gemm_phase<EpiDil, StaticOrder, GEMM_ALIGN, GEMM_SP2>(lds, g, S, E); }
        }
        GRID_SYNC();
        { PH_BEGIN
        if (ON(10)) dil_attn(a, lds);
        }
        GRID_SYNC();
    }
    { PH_BEGIN
    if (ON(11)) dil_merge(a, 1, gw, NGW, lane);
    if (ON(13)) { Gemm g{H, Win + (size_t)WR_GATE * D, T, 16 * 256, D}; StaticOrder S; S.init(T, 16 * 256, G, (int)blockIdx.x);
      EpiGates E{(bf16_t*)(ws + WS_SGA), (bf16_t*)(ws + WS_SGB)};
      pg8::gemm_phase<EpiGates, StaticOrder, GEMM_ALIGN, GEMM_SP2>(lds, g, S, E); }
    }
    GRID_SYNC();
    { PH_BEGIN
    if (ON(14)) { Gemm g{(const bf16_t*)(ws + WS_OA), Wa, T, D, 2048}; StaticOrder S; S.init(T, D, G, (int)blockIdx.x);
      EpiMul<false> E{(const bf16_t*)(ws + WS_SGA), (bf16_t*)(ws + WS_SGA)};
      pg8::gemm_phase<EpiMul<false>, StaticOrder, GEMM_ALIGN, GEMM_SP2>(lds, g, S, E); }
    }
    { PH_BEGIN
    if (ON(15)) { Gemm g{(const bf16_t*)(ws + WS_OB), Wb, T, D, 1024}; StaticOrder S; S.init(T, D, G, (int)blockIdx.x);
      EpiMul<true> E{(const bf16_t*)(ws + WS_SGB), (bf16_t*)(ws + WS_SGA)};
      pg8::gemm_phase<EpiMul<true>, StaticOrder, GEMM_ALIGN, GEMM_SP2>(lds, g, S, E); }
    }
    GRID_SYNC();
    { PH_BEGIN
    if (ON(16)) { Gemm g{(const bf16_t*)(ws + WS_SGA), Wo, T, D, D}; StaticOrder S; S.init(T, D, G, (int)blockIdx.x); EpiRes E{a->out, a->out, mods + 5 * D, 1.0f};
      pg8::gemm_phase<EpiRes, StaticOrder, GEMM_ALIGN, GEMM_SP2>(lds, g, S, E); }
    }
    GRID_SYNC();
    { PH_BEGIN
    if (ON(17)) ln_rows(a->out, a->ln2_g, a->ln2_b, mods, 6, H, gw, NGW, lane);
    }
    GRID_SYNC();
    { PH_BEGIN
    if (ON(18)) { Gemm g{H, Wgu, T, 2 * FF, D}; StaticOrder S; S.init(T, 2 * FF, G, (int)blockIdx.x); EpiGU E{ACT};
      pg8::gemm_phase<EpiGU, StaticOrder, GEMM_ALIGN, GEMM_SP2>(lds, g, S, E); }
    }
    GRID_SYNC();
    { PH_BEGIN
    if (ON(19)) { Gemm g{ACT, Wd, T, D, FF}; StaticOrder S; S.init(T, D, G, (int)blockIdx.x); EpiRes E{a->out, a->out, mods + 8 * D, 0.5f};
      pg8::gemm_phase<EpiRes, StaticOrder, GEMM_ALIGN, GEMM_SP2>(lds, g, S, E); }
    }
    GRID_SYNC();
    { PH_BEGIN
    if (ON(20)) ln_rows(a->out, a->ln3_g, a->ln3_b, mods, 0, nullptr, gw, NGW, lane);
    }
}

extern "C" void kernel_launch(void* const* d_in, const int* in_sizes, int n_in, void* d_out, int out_size, void* d_ws, size_t ws_size, hipStream_t stream) {
    static int grid = 0;
    if (grid == 0) {
        if (n_in != 22 || out_size != T * D || ws_size < WS_END) { fprintf(stderr, "kernel_launch: unexpected shapes: n_in %d out %d ws %zu\n", n_in, out_size, ws_size); grid = -1; return; }
        int dev = 0, cus = 0, per_cu = 0;
        hipGetDevice(&dev); hipDeviceGetAttribute(&cus, hipDeviceAttributeMultiprocessorCount, dev);
        hipFuncSetAttribute((const void*)fwd_megakernel, hipFuncAttributeMaxDynamicSharedMemorySize, LDS_BYTES);
        hipOccupancyMaxActiveBlocksPerMultiprocessor(&per_cu, (const void*)fwd_megakernel, 512, LDS_BYTES);
        (void)hipGetLastError();
        if (per_cu < 1) fprintf(stderr, "kernel_launch: occupancy query says %d blocks/CU\n", per_cu);
        grid = cus;
    }
    if (grid < 0) return;
    Args a{};
    a.x = (const float*)d_in[0]; a.c = (const float*)d_in[1]; a.pos = (const int*)d_in[2]; a.w_ada = (const float*)d_in[3]; a.b_ada = (const float*)d_in[4];
    a.ln1_g = (const float*)d_in[5]; a.ln1_b = (const float*)d_in[6]; a.w_gu1 = (const float*)d_in[7]; a.w_d1 = (const float*)d_in[8];
    a.w_in = (const float*)d_in[9]; a.w_alpha2 = (const float*)d_in[10]; a.b_alpha = (const float*)d_in[11]; a.gla_g = (const float*)d_in[12];
    a.w_a = (const float*)d_in[13]; a.w_b = (const float*)d_in[14]; a.w_o = (const float*)d_in[15]; a.ln2_g = (const float*)d_in[16]; a.ln2_b = (const float*)d_in[17];
    a.w_gu2 = (const float*)d_in[18]; a.w_d2 = (const float*)d_in[19]; a.ln3_g = (const float*)d_in[20]; a.ln3_b = (const float*)d_in[21];
    a.out = (float*)d_out; a.ws = (unsigned char*)d_ws;
    void* args[] = {&a};
    hipError_t e = hipLaunchCooperativeKernel((const void*)fwd_megakernel, dim3(grid), dim3(512), args, LDS_BYTES, stream);
    if (e != hipSuccess) fprintf(stderr, "kernel_launch: cooperative launch failed: %s (grid %d)\n", hipGetErrorString(e), grid);
}
```
